# Optimizing an MI355X kernel written in HIP

```python
import jax, jax.numpy as jnp
from jax import lax
import numpy as np

D_MODEL = 1024
BATCH = 8
SEQ = 8192
DEPTH = 2

MEM_LEN = 256
EPS = 1e-6

CHUNK = 128
A_GROUPS = 4
A_WIDTH = D_MODEL // 2
A_HEAD = A_WIDTH // A_GROUPS
B_WIDTH = D_MODEL // 2
CONV_WIDTH = 3
POOL_WINDOWS = (2, 4, 8, 16)
C_WIDTH = D_MODEL // 2
C_GROUP = C_WIDTH // len(POOL_WINDOWS)
N_BRANCH = 3
IN_SPLITS = (2 * A_WIDTH, 2 * A_WIDTH + 3 * B_WIDTH, 2 * A_WIDTH + 3 * B_WIDTH + C_WIDTH)
IN_COLS = 2 * A_WIDTH + 3 * B_WIDTH + C_WIDTH + N_BRANCH * D_MODEL
XATTN_HEADS = 4
XATTN_HEAD_DIM = D_MODEL // XATTN_HEADS
FFN_HIDDEN = ((-(-8 * D_MODEL // 3) + 255) // 256) * 256

kernel_name = "hybrid_gated_gmlp_conv_pool_xattn_block"


def rmsnorm(x, g):
    xf = x.astype(jnp.float32)
    y = xf * lax.rsqrt(jnp.mean(xf * xf, axis=-1, keepdims=True) + EPS)
    return (y * g.astype(jnp.float32)).astype(x.dtype)


def layernorm(x, g, b):
    xf = x.astype(jnp.float32)
    mu = jnp.mean(xf, axis=-1, keepdims=True)
    var = jnp.mean(jnp.square(xf - mu), axis=-1, keepdims=True)
    y = (xf - mu) * lax.rsqrt(var + EPS)
    return (y * g.astype(jnp.float32) + b.astype(jnp.float32)).astype(x.dtype)


def chunked_spatial_gating(z, ln_g, ln_b, ws, bs):
    u, v = jnp.split(z, 2, axis=-1)
    v = layernorm(v, ln_g, ln_b)
    nb, s, _ = v.shape
    v = v.reshape(nb, s // CHUNK, CHUNK, A_GROUPS, A_HEAD)
    causal = jnp.tril(jnp.ones((CHUNK, CHUNK), dtype=bool))
    w = jnp.where(causal[None], ws, jnp.zeros_like(ws)).astype(v.dtype)
    mixed = jnp.einsum('gij,bcjgd->bcigd', w, v) + bs.T.astype(v.dtype)[None, None, :, :, None]
    return u * mixed.reshape(nb, s, A_WIDTH)


def short_gated_conv(z, w_conv):
    gb, gc, xin = jnp.split(z, 3, axis=-1)
    y = gc * xin
    k = w_conv[:, None, :].astype(y.dtype)
    y = lax.conv_general_dilated(y, k, window_strides=(1,), padding=[(CONV_WIDTH - 1, 0)],
                                 dimension_numbers=('NWC', 'WIO', 'NWC'),
                                 feature_group_count=B_WIDTH)
    return gb * y


def multiscale_pool(z, wg, scale):
    nb, s, _ = z.shape
    zf = z.astype(jnp.float32)
    cs = jnp.concatenate([jnp.zeros((nb, 1, C_WIDTH), jnp.float32), jnp.cumsum(zf, axis=1)], axis=1)
    pos = jnp.arange(s)
    outs = []
    for gi, win in enumerate(POOL_WINDOWS):
        sl = slice(gi * C_GROUP, (gi + 1) * C_GROUP)
        seg = cs[:, :, sl]
        hi = seg[:, 1:]
        lo = jnp.concatenate([jnp.zeros((nb, win - 1, C_GROUP), jnp.float32), seg[:, :s - win + 1]], axis=1)
        count = jnp.minimum(pos + 1, win).astype(jnp.float32)[None, :, None]
        outs.append((hi - lo) / count - zf[:, :, sl])
    p = jnp.stack(outs, axis=2)
    p = jnp.einsum('bsgc,gcd->bsgd', p, wg.astype(jnp.float32)).reshape(nb, s, C_WIDTH)
    return (p * scale.astype(jnp.float32)).astype(z.dtype)


def mixer_block(x, g_mix, w_in, b_gate, a_ln_g, a_ln_b, a_ws, a_bs, b_conv, c_wg, c_scale,
                w_branch_a, w_branch_b, w_branch_c, w_o):
    nb, s, _ = x.shape
    h = rmsnorm(x, g_mix)
    proj = h @ w_in
    za, zb, zc, zg = jnp.split(proj, IN_SPLITS, axis=-1)
    ya = chunked_spatial_gating(jax.nn.gelu(za, approximate=False), a_ln_g, a_ln_b, a_ws, a_bs) @ w_branch_a
    yb = short_gated_conv(zb, b_conv) @ w_branch_b
    yc = multiscale_pool(zc, c_wg, c_scale) @ w_branch_c
    gates = jax.nn.sigmoid(zg.reshape(nb, s, N_BRANCH, D_MODEL) + b_gate)
    merged = gates[:, :, 0] * ya + gates[:, :, 1] * yb + gates[:, :, 2] * yc
    return x + merged @ w_o


def cross_attention(x, mem, g_x, g_m, w_q, w_kv, w_o):
    nb, s, _ = x.shape
    hq = rmsnorm(x, g_x)
    m = rmsnorm(mem, g_m)
    q = (hq @ w_q).reshape(nb, s, XATTN_HEADS, XATTN_HEAD_DIM)
    k, v = jnp.split(m @ w_kv, 2, axis=-1)
    k = k.reshape(nb, MEM_LEN, XATTN_HEADS, XATTN_HEAD_DIM)
    v = v.reshape(nb, MEM_LEN, XATTN_HEADS, XATTN_HEAD_DIM)
    sc = jnp.einsum('bshd,bmhd->bhsm', q, k).astype(jnp.float32) * (XATTN_HEAD_DIM ** -0.5)
    p = jax.nn.softmax(sc, axis=-1).astype(v.dtype)
    o = jnp.einsum('bhsm,bmhd->bshd', p, v).reshape(nb, s, D_MODEL)
    return x + o @ w_o


def swiglu_ffn(x, g, w_in, w_out):
    h = rmsnorm(x, g)
    gate, up = jnp.split(h @ w_in, 2, axis=-1)
    return x + (jax.nn.silu(gate) * up) @ w_out


def setup_inputs(seed: int = 0) -> dict:
    key = jax.random.key(seed)
    ks = jax.random.split(key, 32)
    f32 = jnp.float32
    L, D = DEPTH, D_MODEL

    def nrm(k, shape, fan_in):
        return jax.random.normal(k, shape, f32) * (fan_in ** -0.5)

    def gain(k, shape):
        return 1.0 + 0.02 * jax.random.normal(k, shape, f32)

    def small(k, shape, s=0.02):
        return s * jax.random.normal(k, shape, f32)

    return {
        "x": jax.random.normal(ks[0], (BATCH, SEQ, D), f32),
        "mem": jax.random.normal(ks[1], (BATCH, MEM_LEN, D), f32),
        "g_mix": gain(ks[2], (L, D)),
        "w_in": nrm(ks[3], (L, D, IN_COLS), D),
        "b_gate": small(ks[4], (L, N_BRANCH, D), 0.01),
        "a_ln_g": gain(ks[5], (L, A_WIDTH)),
        "a_ln_b": small(ks[6], (L, A_WIDTH)),
        "a_ws": nrm(ks[7], (L, A_GROUPS, CHUNK, CHUNK), CHUNK),
        "a_bs": gain(ks[8], (L, A_GROUPS, CHUNK)),
        "b_conv": nrm(ks[9], (L, CONV_WIDTH, B_WIDTH), CONV_WIDTH),
        "c_wg": nrm(ks[10], (L, len(POOL_WINDOWS), C_GROUP, C_GROUP), C_GROUP),
        "c_scale": gain(ks[11], (L, C_WIDTH)),
        "w_branch_a": nrm(ks[12], (L, A_WIDTH, D), A_WIDTH),
        "w_branch_b": nrm(ks[13], (L, B_WIDTH, D), B_WIDTH),
        "w_branch_c": nrm(ks[14], (L, C_WIDTH, D), C_WIDTH),
        "w_o": nrm(ks[15], (L, D, D), D),
        "g_xattn": gain(ks[16], (L, D)),
        "g_mem": gain(ks[17], (L, D)),
        "w_xq": nrm(ks[18], (L, D, D), D),
        "w_xkv": nrm(ks[19], (L, D, 2 * D), D),
        "w_xo": nrm(ks[20], (L, D, D), D),
        "g_ffn": gain(ks[21], (L, D)),
        "w_ffn_in": nrm(ks[22], (L, D, 2 * FFN_HIDDEN), D),
        "w_ffn_out": nrm(ks[23], (L, FFN_HIDDEN, D), FFN_HIDDEN),
        "g_final": gain(ks[24], (D,)),
    }


def reference(x, mem, g_mix, w_in, b_gate, a_ln_g, a_ln_b, a_ws, a_bs, b_conv, c_wg, c_scale,
              w_branch_a, w_branch_b, w_branch_c, w_o, g_xattn, g_mem, w_xq, w_xkv, w_xo,
              g_ffn, w_ffn_in, w_ffn_out, g_final):
    for l in range(DEPTH):
        x = mixer_block(x, g_mix[l], w_in[l], b_gate[l], a_ln_g[l], a_ln_b[l], a_ws[l], a_bs[l],
                        b_conv[l], c_wg[l], c_scale[l], w_branch_a[l], w_branch_b[l], w_branch_c[l], w_o[l])
        x = cross_attention(x, mem, g_xattn[l], g_mem[l], w_xq[l], w_xkv[l], w_xo[l])
        x = swiglu_ffn(x, g_ffn[l], w_ffn_in[l], w_ffn_out[l])
    return rmsnorm(x, g_final)
```

```cpp
#include <hip/hip_runtime.h>
#include <hip/hip_cooperative_groups.h>
#include <cstdio>
#include <cstdint>
namespace cg = cooperative_groups;

#define LAS __attribute__((address_space(3)))
typedef unsigned short bf16_t;
typedef short bf16x8 __attribute__((ext_vector_type(8)));
typedef float f32x4 __attribute__((ext_vector_type(4)));
typedef float f32x2 __attribute__((ext_vector_type(2)));
typedef unsigned u32x4 __attribute__((ext_vector_type(4)));
typedef unsigned u32x2 __attribute__((ext_vector_type(2)));

constexpr int MTOK = 65536, DM = 1024, INC = 6144, FFH = 2816, SEQL = 8192, MEMROWS = 2048;
constexpr float EPSV = 1e-6f;
constexpr float L2E = 1.4426950408889634f;
constexpr size_t MiB = 1u << 20;
constexpr size_t WS_WT = 1 * MiB, LW = 42 * MiB;
constexpr size_t OFF_WIN = 0, OFF_WA = 12 * MiB, OFF_WO = 15 * MiB, OFF_WQ = 17 * MiB, OFF_WK = 19 * MiB, OFF_WV = 21 * MiB, OFF_WXO = 23 * MiB,
                 OFF_WFI = 25 * MiB, OFF_WFO = 36 * MiB, OFF_WS = 41 * MiB + 512 * 1024, OFF_WG = OFF_WS + 128 * 1024;
constexpr size_t WS_KB = WS_WT + 2 * LW;
constexpr size_t WS_VT = WS_KB + 8 * MiB;
constexpr size_t WS_MEMN = WS_VT + 8 * MiB;
constexpr size_t WS_SSQ = WS_MEMN + 4 * MiB;
constexpr size_t WS_XB = WS_SSQ + 4 * MiB;
constexpr size_t WS_PROJ = WS_XB + 128 * MiB;
constexpr size_t WS_END = WS_PROJ + 768 * MiB;
constexpr size_t PJ_P = 0, PJ_H = 1 * MiB;
constexpr size_t XSP_1024 = 3 * MiB - (size_t)256 * 1024 * 2, XSP_FFH = 3 * MiB - (size_t)256 * FFH * 2;
constexpr int LDS_BYTES = 147456;
constexpr int LDS_MISC = 131072 + 8192;
constexpr int LDS_STAT = 131072;

typedef __bf16 bf16x2_t __attribute__((ext_vector_type(2)));
__device__ __forceinline__ unsigned cvt_pk_bf16(float lo, float hi) { const bf16x2_t r = __builtin_convertvector((f32x2){lo, hi}, bf16x2_t); return __builtin_bit_cast(unsigned, r); }
__device__ __forceinline__ unsigned f2bf(float f) { unsigned u = __builtin_bit_cast(unsigned, f); return (u + 0x7fffu + ((u >> 16) & 1u)) >> 16; }
__device__ __forceinline__ unsigned pk2(float lo, float hi) { return f2bf(lo) | (f2bf(hi) << 16); }
__device__ __forceinline__ float bf_lo(unsigned u) { return __builtin_bit_cast(float, u << 16); }
__device__ __forceinline__ float bf_hi(unsigned u) { return __builtin_bit_cast(float, u & 0xffff0000u); }
__device__ __forceinline__ void unpack8(const u32x4 w, f32x4& a, f32x4& b) { a = (f32x4){bf_lo(w.x), bf_hi(w.x), bf_lo(w.y), bf_hi(w.y)}; b = (f32x4){bf_lo(w.z), bf_hi(w.z), bf_lo(w.w), bf_hi(w.w)}; }
__device__ __forceinline__ u32x4 pack8(const f32x4 a, const f32x4 b) { u32x4 w; w.x = cvt_pk_bf16(a[0], a[1]); w.y = cvt_pk_bf16(a[2], a[3]); w.z = cvt_pk_bf16(b[0], b[1]); w.w = cvt_pk_bf16(b[2], b[3]); return w; }
__device__ __forceinline__ int phase_tid(int wave_s) { int lane; asm volatile("v_mbcnt_lo_u32_b32 %0, -1, 0\n\tv_mbcnt_hi_u32_b32 %0, -1, %0" : "=v"(lane)); return wave_s * 64 + lane; }
__device__ __forceinline__ float wave_sum(float v) {
#pragma unroll
    for (int o = 1; o < 64; o <<= 1) v += __shfl_xor(v, o);
    return v;
}
__device__ __forceinline__ float fast_sigmoid(float x) { return __builtin_amdgcn_rcpf(1.0f + __builtin_amdgcn_exp2f(-x * L2E)); }
#define ROWFENCE() asm volatile("" ::: "memory")
#define GRID_SYNC() do { if (local_ok) xcc_local_barrier((unsigned*)a.ws, XB_XSUB(xcc), 32u, epoch, leader); else xcd_barrier(xbar, leader); } while (0)
#define TEAM_SYNC() do { if (local_ok) xcc_local_barrier((unsigned*)a.ws, XB_TEAM(8u * xcc + (ticket & 7u)), 4u, epoch_t, leader); else xcd_barrier(xbar, leader); } while (0)
#define CG_GRID_SYNC() do { asm volatile("s_waitcnt vmcnt(0) lgkmcnt(0)" ::: "memory"); grid.sync(); __builtin_amdgcn_fence(__ATOMIC_ACQUIRE, "agent"); asm volatile("s_waitcnt vmcnt(0)" ::: "memory"); } while (0)

namespace pg8 {
constexpr int BM = 256, BK = 64, HALF = 128, HTB = HALF * BK * 2, STAGE_BYTES = 8 * HTB, NXCD = 8, WGM = 8;
__host__ __device__ __forceinline__ int lds_byte(int r, int c) { const int st = (r >> 4) * 2 + (c >> 5), rr = r & 15, cc = c & 31, ob = rr * 64 + cc * 2; return st * 1024 + (ob ^ (((ob >> 9) & 1) << 5)); }
__host__ __device__ __forceinline__ void stage_rc(int b, int& R, int& C) { const int st = b / 1024, sb = b % 1024, swz = sb ^ (((sb >> 9) & 1) << 5); R = (st >> 1) * 16 + swz / 64; C = (st & 1) * 32 + (swz % 64) / 2; }
__host__ __device__ __forceinline__ int perm32(int rho) { const int n = rho >> 4, i = rho & 15; return 8 * (i >> 2) + 4 * n + (i & 3); }

struct Unit { int pm, pn, seg; const char* A; const char* B; };
struct Gemm { int K, lda, ldb; };

struct StaticOrder {
    int nM, nN, nwg, G, c;
    __device__ void init(int M, int N, int G_, int c_) { nM = M / BM; nN = N / BM; nwg = nM * nN; G = G_; c = c_; }
    __device__ bool tile(int i, int& pm, int& pn) const {
        const long L = (long)i * G + c; if (L >= nwg) return false;
        int wgid = (int)L; { const int q = nwg / NXCD, r = nwg % NXCD, xcd = wgid % NXCD, off = wgid / NXCD; wgid = (xcd < r ? xcd * (q + 1) : r * (q + 1) + (xcd - r) * q) + off; }
        const int nig = WGM * nN, gid = wgid / nig, fm = gid * WGM, gsz = (nM - fm) < WGM ? (nM - fm) : WGM;
        pm = fm + ((wgid % nig) % gsz); pn = (wgid % nig) / gsz; return true;
    }
};
struct PlainOrder {
    StaticOrder so; const char* A; const char* B; size_t astep, bstep, axs, bxs = 0;
    __device__ bool next(int i, Unit& u) const { int pm, pn; if (!so.tile(i, pm, pn)) return false; u.pm = pm; u.pn = pn; u.seg = 0; u.A = A + (size_t)pm * (astep + axs); u.B = B + (size_t)pn * bstep + (size_t)(pm >> 5) * bxs; return true; }
};

template <class Epi, class Sched>
__device__ __forceinline__ void gemm_phase(LAS unsigned char* lds, const Gemm g, const Sched& S, const Epi& E, int wave_s) {
    const int tid_ = phase_tid(wave_s);
    const int tid = tid_, wid = __builtin_amdgcn_readfirstlane(tid >> 6), lane = tid & 63, wr = wid >> 2, wc = wid & 3, fr = lane & 15, fq = lane >> 4;
    const int K = g.K, nt = K / BK;
    unsigned voffA[2], voffB[2];
#pragma unroll
    for (int i = 0; i < 2; ++i) { int R, C; stage_rc(tid * 16 + i * 8192, R, C); const int Rb = Epi::PERM ? ((R & ~31) + perm32(R & 31)) : R;
        voffA[i] = (unsigned)(R * g.lda + C) * 2u; voffB[i] = (unsigned)(Rb * g.ldb + C) * 2u; }
    const size_t kstep = (size_t)(BK * 2);
    const size_t hstepA = (size_t)HALF * g.lda * 2, hstepB = (size_t)HALF * g.ldb * 2;
    const unsigned ldsw = (unsigned)wid * 1024u;
    const int aoff = lds_byte(wr * 64 + fr, fq * 8), boff = lds_byte(wc * 32 + fr, fq * 8);
#define PG8_SA(b, h) (((b) * 2 + (h)) * HTB)
#define PG8_SB(b, h) ((4 + (b) * 2 + (h)) * HTB)
#define PG8_STAGE(bufoff, gbase, voff) do { _Pragma("unroll") for (int _i = 0; _i < 2; ++_i) \
        __builtin_amdgcn_global_load_lds((const unsigned*)((const char*)(gbase) + (voff)[_i]), (LAS unsigned*)(lds + (bufoff) + ldsw + _i * 8192), 16, 0, 0); } while (0)
#define PG8_LDA(dst, b, h) do { _Pragma("unroll") for (int m = 0; m < 4; ++m) _Pragma("unroll") for (int k = 0; k < 2; ++k) dst[m][k] = *(const LAS bf16x8*)(lds + PG8_SA(b, h) + aoff + m * 2048 + k * 1024); } while (0)
#define PG8_LDB(dst, b, h) do { _Pragma("unroll") for (int n = 0; n < 2; ++n) _Pragma("unroll") for (int k = 0; k < 2; ++k) dst[n][k] = *(const LAS bf16x8*)(lds + PG8_SB(b, h) + boff + n * 2048 + k * 1024); } while (0)
#define PG8_MMA(ai, bj, At, Bt) do { __builtin_amdgcn_s_setprio(1); _Pragma("unroll") for (int m = 0; m < 4; ++m) _Pragma("unroll") for (int n = 0; n < 2; ++n) _Pragma("unroll") for (int k = 0; k < 2; ++k) \
        acc[ai][bj][m][n] = __builtin_amdgcn_mfma_f32_16x16x32_bf16(Bt[n][k], At[m][k], acc[ai][bj][m][n], 0, 0, 0); __builtin_amdgcn_s_setprio(0); } while (0)
#define PG8_WAIT_V(n) asm volatile("s_waitcnt vmcnt(" #n ")" ::: "memory")
#define PG8_WAIT_L(n) asm volatile("s_waitcnt lgkmcnt(" #n ")" ::: "memory")
#define PG8_BAR __builtin_amdgcn_s_barrier()
#define PG8_SCHED __builtin_amdgcn_sched_barrier(0)
    Unit cur, nxt; int ui = 0;
    if (!S.next(0, cur)) return;
    f32x4 acc[2][2][4][2];
    if constexpr (Epi::INIT) E.first_init(acc, cur, wr, wc, fr, fq);
    else {
#pragma unroll
    for (int a = 0; a < 2; ++a)
#pragma unroll
        for (int b = 0; b < 2; ++b)
#pragma unroll
            for (int m = 0; m < 4; ++m)
#pragma unroll
                for (int n = 0; n < 2; ++n) acc[a][b][m][n] = (f32x4){0.f, 0.f, 0.f, 0.f};
    }
    bf16x8 At[4][2], B0[2][2], B1[2][2];
    const char* cA = cur.A; const char* cB = cur.B;
    typename Epi::Pre pre; E.prefetch(pre, cur, wr, fr, fq);
    PG8_STAGE(PG8_SB(0, 0), cB, voffB); PG8_STAGE(PG8_SB(0, 1), cB + hstepB, voffB); PG8_STAGE(PG8_SA(0, 0), cA, voffA); PG8_STAGE(PG8_SA(0, 1), cA + hstepA, voffA);
    if (wr == 1) PG8_BAR;
    PG8_WAIT_V(2); PG8_BAR;
    PG8_STAGE(PG8_SB(1, 0), cB + kstep, voffB); PG8_STAGE(PG8_SA(1, 0), cA + kstep, voffA); PG8_STAGE(PG8_SB(1, 1), cB + hstepB + kstep, voffB);
    PG8_WAIT_V(6); PG8_BAR;
    for (;;) {
        const bool has_next = S.next(ui + 1, nxt);
        const char* nA = has_next ? nxt.A : cA; const char* nB = has_next ? nxt.B : cB;
#pragma unroll 1
        for (int t = 0; t < nt; t += 2) {
            const bool last = (t == nt - 2);
            const char* a1 = cA + (size_t)(t + 1) * kstep;
            const char* a2 = last ? nA : cA + (size_t)(t + 2) * kstep; const char* b2 = last ? nB : cB + (size_t)(t + 2) * kstep;
            const char* a3 = a2 + kstep; const char* b3 = b2 + kstep;
            PG8_LDB(B0, 0, 0); PG8_LDB(B1, 0, 1); PG8_SCHED; PG8_LDA(At, 0, 0); PG8_STAGE(PG8_SA(1, 1), a1 + hstepA, voffA);
            PG8_WAIT_V(8); PG8_WAIT_L(0); PG8_BAR; PG8_MMA(0, 0, At, B0); PG8_MMA(0, 1, At, B1); PG8_BAR; PG8_SCHED;
            PG8_LDA(At, 0, 1); PG8_STAGE(PG8_SB(0, 0), b2, voffB); PG8_STAGE(PG8_SB(0, 1), b2 + hstepB, voffB); PG8_STAGE(PG8_SA(0, 0), a2, voffA);
            PG8_WAIT_V(8); PG8_WAIT_L(0); PG8_BAR; PG8_MMA(1, 0, At, B0); PG8_MMA(1, 1, At, B1); PG8_BAR; PG8_SCHED;
            PG8_LDB(B0, 1, 0); PG8_LDB(B1, 1, 1); PG8_SCHED; PG8_LDA(At, 1, 0); PG8_STAGE(PG8_SA(0, 1), a2 + hstepA, voffA);
            PG8_WAIT_V(8); PG8_WAIT_L(0); PG8_BAR; PG8_MMA(0, 0, At, B0); PG8_MMA(0, 1, At, B1); PG8_BAR; PG8_SCHED;
            PG8_LDA(At, 1, 1); PG8_STAGE(PG8_SB(1, 0), b3, voffB); PG8_STAGE(PG8_SB(1, 1), b3 + hstepB, voffB); PG8_STAGE(PG8_SA(1, 0), a3, voffA);
            PG8_WAIT_V(8); PG8_WAIT_L(0); PG8_BAR; PG8_MMA(1, 0, At, B0); PG8_MMA(1, 1, At, B1); PG8_BAR; PG8_SCHED;
        }
        if (wr == 0) PG8_BAR;
        typename Epi::Init itn;
        if constexpr (Epi::INIT) { if (has_next) E.load_init(itn, nxt, wr, wc, fr, fq); }
        E(acc, cur, wr, wc, fr, fq, pre);
        if (!has_next) break;
        if constexpr (Epi::INIT) E.apply_init(acc, itn, nxt, wr, wc, fr, fq);
        else if (!(Epi::MULTISEG && nxt.seg != 0)) {
#pragma unroll
            for (int a = 0; a < 2; ++a)
#pragma unroll
                for (int b = 0; b < 2; ++b)
#pragma unroll
                    for (int m = 0; m < 4; ++m)
#pragma unroll
                        for (int n = 0; n < 2; ++n) acc[a][b][m][n] = (f32x4){0.f, 0.f, 0.f, 0.f};
        }
        cur = nxt; cA = nA; cB = nB; ++ui;
        E.prefetch(pre, cur, wr, fr, fq);
        if (wr == 1) PG8_BAR;
    }
    PG8_WAIT_V(0);
    PG8_BAR;
#undef PG8_SA
#undef PG8_SB
#undef PG8_STAGE
#undef PG8_LDA
#undef PG8_LDB
#undef PG8_MMA
#undef PG8_WAIT_V
#undef PG8_WAIT_L
#undef PG8_BAR
#undef PG8_SCHED
}
}
using pg8::Unit;

__device__ __forceinline__ f32x2 gelu_pk(f32x2 v) {
    const f32x2 av = __builtin_elementwise_abs(v), d = av * 0.2316418882f + 1.0f;
    f32x2 t; t.x = __builtin_amdgcn_rcpf(d.x); t.y = __builtin_amdgcn_rcpf(d.y);
    f32x2 q = t * 0.5307027145f + (-0.7265760135f); q = q * t + 0.7107068705f; q = q * t + (-0.142248368f); q = q * t + 0.127414796f; q = q * t;
    const f32x2 s = (v * v) * (-0.72134752044f);
    f32x2 e; e.x = __builtin_amdgcn_exp2f(s.x); e.y = __builtin_amdgcn_exp2f(s.y);
    const f32x2 m = v * (q * e), r = v - m;
    f32x2 o; o.x = v.x < 0.f ? m.x : r.x; o.y = v.y < 0.f ? m.y : r.y; return o;
}
__device__ __forceinline__ f32x4 gelu4(f32x4 v) { const f32x2 a = gelu_pk((f32x2){v[0], v[1]}), b = gelu_pk((f32x2){v[2], v[3]}); return (f32x4){a.x, a.y, b.x, b.y}; }

struct NoPre { };
struct RowPre { float s[8]; };
__device__ __forceinline__ void load_rowpre(RowPre& p, const float* ssq, int pm, int wr, int fr, int fq) {
#pragma unroll
    for (int k = 0; k < 8; ++k) p.s[k] = ssq[(size_t)(pm * 256 + (k >> 2) * 128 + wr * 64 + (k & 3) * 16 + fr) * 4 + fq];
}
__device__ __forceinline__ float rstd_from(float s) { s += __shfl_xor(s, 16); s += __shfl_xor(s, 32); return __builtin_amdgcn_rsqf(s * (1.0f / 1024.0f) + EPSV); }
typedef f32x4 AccT[2][2][4][2];

struct EpiInProj {
    static constexpr bool PERM = true, MULTISEG = false;
    typedef RowPre Pre; __device__ __forceinline__ void prefetch(Pre& p, const Unit& u, int wr, int fr, int fq) const { load_rowpre(p, ssq, u.pm, wr, fr, fq); }
    static constexpr bool INIT = false; typedef NoPre Init;
    bf16_t* P; const float* ssq; const float* bgate;
    __device__ __forceinline__ void operator()(AccT& acc, const Unit& u, int wr, int wc, int fr, int fq, const Pre& pre) const {
        const int row0 = u.pm * 256 + wr * 64 + fr, col0 = u.pn * 256 + wc * 32 + 8 * fq;
        const int mode = u.pn < 4 ? 0 : (u.pn < 6 ? 1 : (u.pn < 10 ? 3 : (u.pn < 12 ? 1 : 2)));
        f32x4 bv[2][2];
#pragma unroll
        for (int bj = 0; bj < 2; ++bj)
#pragma unroll
            for (int n = 0; n < 2; ++n) bv[bj][n] = (mode == 2) ? *(const f32x4*)(bgate + (col0 - 3072) + bj * 128 + 4 * n) : (f32x4){0.f, 0.f, 0.f, 0.f};
#pragma unroll
        for (int ai = 0; ai < 2; ++ai)
#pragma unroll
            for (int m = 0; m < 4; ++m) {
                const int row = row0 + ai * 128 + m * 16; const float rs = rstd_from(pre.s[ai * 4 + m]);
                bf16_t* rp = P + (size_t)row * INC + col0;
#pragma unroll
                for (int bj = 0; bj < 2; ++bj) {
                    f32x4 v0 = acc[ai][bj][m][0] * rs, v1 = acc[ai][bj][m][1] * rs;
                    if (mode == 0) { v0 = gelu4(v0); v1 = gelu4(v1); }
                    if (mode == 2) { v0 = v0 + bv[bj][0]; v1 = v1 + bv[bj][1];
#pragma unroll
                        for (int j = 0; j < 4; ++j) { v0[j] = fminf(__builtin_amdgcn_exp2f(-v0[j] * L2E), 1e30f); v1[j] = fminf(__builtin_amdgcn_exp2f(-v1[j] * L2E), 1e30f); } }
                    if (mode == 3) { const f32x4 y = v0 * v1; u32x2 w; w.x = cvt_pk_bf16(y[0], y[1]); w.y = cvt_pk_bf16(y[2], y[3]);
                        *(u32x2*)(P + (size_t)row * INC + 1536 + (u.pn - 6) * 128 + bj * 64 + wc * 16 + 4 * fq) = w; }
                    else *(u32x4*)(rp + bj * 128) = pack8(v0, v1);
                }
            }
    }
};
struct EpiKV {
    static constexpr bool PERM = true, MULTISEG = false;
    typedef NoPre Pre; __device__ __forceinline__ void prefetch(Pre&, const Unit&, int, int, int) const {}
    static constexpr bool INIT = false; typedef NoPre Init;
    bf16_t* KB; bf16_t* VT;
    __device__ __forceinline__ void operator()(AccT& acc, const Unit& u, int wr, int wc, int fr, int fq, const Pre& pre) const {
        const int l = u.seg >> 1, isv = u.seg & 1;
        bf16_t* O = KB + (size_t)isv * ((WS_VT - WS_KB) / 2) + (size_t)l * 2048 * 1024; const int ldc = 1024;
        const int row0 = u.pm * 256 + wr * 64 + fr, col0 = u.pn * 256 + wc * 32 + 8 * fq;
#pragma unroll
        for (int ai = 0; ai < 2; ++ai)
#pragma unroll
            for (int m = 0; m < 4; ++m) { bf16_t* rp = O + (size_t)(row0 + ai * 128 + m * 16) * ldc + col0;
#pragma unroll
                for (int bj = 0; bj < 2; ++bj) *(u32x4*)(rp + bj * 128) = pack8(acc[ai][bj][m][0], acc[ai][bj][m][1]); }
    }
};
struct EpiPre {
    static constexpr bool PERM = true, MULTISEG = false;
    typedef NoPre Pre; __device__ __forceinline__ void prefetch(Pre&, const Unit&, int, int, int) const {}
    static constexpr bool INIT = false; typedef NoPre Init;
    bf16_t* WQKT;
    __device__ __forceinline__ void operator()(AccT& acc, const Unit& u, int wr, int wc, int fr, int fq, const Pre& pre) const {
        bf16_t* O = WQKT + (size_t)(u.seg & 7) * ((size_t)16 * 1024 * 1024) + (size_t)(u.seg >> 4) * ((size_t)2 * 1024 * 1024) + (size_t)((u.seg >> 3) & 1) * 1024 * 1024;
        const int row0 = u.pm * 256 + wr * 64 + fr, col0 = u.pn * 256 + wc * 32 + 8 * fq;
#pragma unroll
        for (int ai = 0; ai < 2; ++ai)
#pragma unroll
            for (int m = 0; m < 4; ++m) { bf16_t* rp = O + (size_t)(row0 + ai * 128 + m * 16) * 1024 + col0;
#pragma unroll
                for (int bj = 0; bj < 2; ++bj) *(u32x4*)(rp + bj * 128) = pack8(acc[ai][bj][m][0], acc[ai][bj][m][1]); }
    }
};
struct EpiBranch {
    static constexpr bool PERM = true, MULTISEG = true;
    typedef NoPre Pre; __device__ __forceinline__ void prefetch(Pre&, const Unit&, int, int, int) const {}
    static constexpr bool INIT = false; typedef NoPre Init;
    bf16_t* P;
    __device__ __forceinline__ void operator()(AccT& acc, const Unit& u, int wr, int wc, int fr, int fq, const Pre& pre) const {
        const int row0 = u.pm * 256 + wr * 64 + fr, col0 = u.pn * 256 + wc * 32 + 8 * fq;
        const int seg = u.seg;
#pragma unroll
        for (int ai = 0; ai < 2; ++ai)
#pragma unroll
            for (int m = 0; m < 4; ++m) {
                bf16_t* rp = P + (size_t)(row0 + ai * 128 + m * 16) * INC + col0;
#pragma unroll
                for (int bj = 0; bj < 2; ++bj) {
                    f32x4 a0, a1; unpack8(*(const u32x4*)(rp + 3072 + seg * 1024 + bj * 128), a0, a1);
#pragma unroll
                    for (int j = 0; j < 4; ++j) { a0[j] = __builtin_amdgcn_rcpf(1.0f + a0[j]); a1[j] = __builtin_amdgcn_rcpf(1.0f + a1[j]); }
                    if (seg < 2) { f32x4 b0, b1; unpack8(*(const u32x4*)(rp + 4096 + seg * 1024 + bj * 128), b0, b1);
                        a0 *= (b0 + 1.0f); a1 *= (b1 + 1.0f); }
                    acc[ai][bj][m][0] *= a0; acc[ai][bj][m][1] *= a1;
                    if (seg == 2) *(u32x4*)(rp + 1536 + bj * 128) = pack8(acc[ai][bj][m][0], acc[ai][bj][m][1]);
                }
                if (m == 3) ROWFENCE();
            }
    }
};
struct EpiResid {
    static constexpr bool PERM = true, MULTISEG = false;
    typedef NoPre Pre; __device__ __forceinline__ void prefetch(Pre&, const Unit&, int, int, int) const {}
    static constexpr int NPRE = 2;
    static constexpr bool INIT = true; struct Init { u32x4 x[NPRE][2]; };
    bf16_t* X; float* ssq; LAS float* st;
    __device__ __forceinline__ const bf16_t* xptr(const Unit& u, int wr, int wc, int fr, int fq) const { return X + (size_t)(u.pm * 256 + wr * 64 + fr) * DM + u.pn * 256 + wc * 32 + 8 * fq; }
    __device__ __forceinline__ void load_init(Init& it, const Unit& u, int wr, int wc, int fr, int fq) const {
        const bf16_t* xp = xptr(u, wr, wc, fr, fq);
#pragma unroll
        for (int m = 0; m < NPRE; ++m)
#pragma unroll
            for (int bj = 0; bj < 2; ++bj) it.x[m][bj] = *(const u32x4*)(xp + (size_t)(m * 16) * DM + bj * 128);
    }
    __device__ __forceinline__ void apply_init(AccT& acc, const Init& it, const Unit& u, int wr, int wc, int fr, int fq) const {
        const bf16_t* xp = xptr(u, wr, wc, fr, fq);
#pragma unroll
        for (int m = 0; m < NPRE; ++m)
#pragma unroll
            for (int bj = 0; bj < 2; ++bj) unpack8(it.x[m][bj], acc[0][bj][m][0], acc[0][bj][m][1]);
#pragma unroll
        for (int k = NPRE; k < 8; ++k) { const int ai = k >> 2, m = k & 3;
#pragma unroll
            for (int bj = 0; bj < 2; ++bj) unpack8(*(const u32x4*)(xp + (size_t)(ai * 128 + m * 16) * DM + bj * 128), acc[ai][bj][m][0], acc[ai][bj][m][1]);
        }
    }
    __device__ __forceinline__ void first_init(AccT& acc, const Unit& u, int wr, int wc, int fr, int fq) const {
        const bf16_t* xp = xptr(u, wr, wc, fr, fq);
#pragma unroll
        for (int ai = 0; ai < 2; ++ai)
#pragma unroll
            for (int m = 0; m < 4; ++m) {
#pragma unroll
                for (int bj = 0; bj < 2; ++bj) unpack8(*(const u32x4*)(xp + (size_t)(ai * 128 + m * 16) * DM + bj * 128), acc[ai][bj][m][0], acc[ai][bj][m][1]);
                if (m & 1) ROWFENCE();
            }
    }
    __device__ __forceinline__ void operator()(AccT& acc, const Unit& u, int wr, int wc, int fr, int fq, const Pre& pre) const {
        const int row0 = u.pm * 256 + wr * 64 + fr, col0 = u.pn * 256 + wc * 32 + 8 * fq;
#pragma unroll
        for (int ai = 0; ai < 2; ++ai)
#pragma unroll
            for (int m = 0; m < 4; ++m) {
                const int row = row0 + ai * 128 + m * 16; bf16_t* rp = X + (size_t)row * DM + col0; float ss = 0.f;
#pragma unroll
                for (int bj = 0; bj < 2; ++bj) {
                    const f32x4 x0 = acc[ai][bj][m][0], x1 = acc[ai][bj][m][1];
                    ss += (x0[0] * x0[0] + x0[1] * x0[1]) + (x0[2] * x0[2] + x0[3] * x0[3]) + (x1[0] * x1[0] + x1[1] * x1[1]) + (x1[2] * x1[2] + x1[3] * x1[3]);
                    *(u32x4*)(rp + bj * 128) = pack8(x0, x1);
                }
                ss += __shfl_xor(ss, 16); ss += __shfl_xor(ss, 32);
                if (fq == 0) st[(ai * 128 + wr * 64 + m * 16 + fr) * 4 + wc] = ss;
            }
        asm volatile("s_waitcnt lgkmcnt(0)" ::: "memory"); __builtin_amdgcn_s_barrier(); asm volatile("" ::: "memory");
        const int t = (wr * 4 + wc) * 64 + fq * 16 + fr;
        if (t < 256) { const f32x4 p = *(const LAS f32x4*)(st + t * 4); ssq[(size_t)(u.pm * 256 + t) * 4 + u.pn] = (p[0] + p[1]) + (p[2] + p[3]); }
    }
};
struct EpiSwiglu {
    static constexpr bool PERM = true, MULTISEG = false;
    typedef RowPre Pre; __device__ __forceinline__ void prefetch(Pre& p, const Unit& u, int wr, int fr, int fq) const { load_rowpre(p, ssq, u.pm, wr, fr, fq); }
    static constexpr bool INIT = false; typedef NoPre Init;
    bf16_t* H; const float* ssq;
    __device__ __forceinline__ void operator()(AccT& acc, const Unit& u, int wr, int wc, int fr, int fq, const Pre& pre) const {
        const int row0 = u.pm * 256 + wr * 64 + fr, h0 = u.pn * 128 + wc * 16 + 4 * fq;
#pragma unroll
        for (int ai = 0; ai < 2; ++ai)
#pragma unroll
            for (int m = 0; m < 4; ++m) {
                const int row = row0 + ai * 128 + m * 16; const float rs = rstd_from(pre.s[ai * 4 + m]);
                bf16_t* rp = H + (size_t)u.pm * (XSP_FFH / 2) + (size_t)row * FFH + h0;
#pragma unroll
                for (int bj = 0; bj < 2; ++bj) {
                    const f32x4 gt = acc[ai][bj][m][0] * rs, up = acc[ai][bj][m][1] * rs; f32x4 o;
#pragma unroll
                    for (int j = 0; j < 4; ++j) o[j] = gt[j] * fast_sigmoid(gt[j]) * up[j];
                    u32x2 w; w.x = cvt_pk_bf16(o[0], o[1]); w.y = cvt_pk_bf16(o[2], o[3]);
                    *(u32x2*)(rp + bj * 64) = w;
                }
            }
    }
};
struct EpiSoftmax {
    static constexpr bool PERM = true, MULTISEG = false;
    typedef RowPre Pre; __device__ __forceinline__ void prefetch(Pre& p, const Unit& u, int wr, int fr, int fq) const { load_rowpre(p, ssq, u.pm, wr, fr, fq); }
    static constexpr bool INIT = false; typedef NoPre Init;
    bf16_t* Pout; LAS float* st; const float* ssq;
    __device__ __forceinline__ void operator()(AccT& acc, const Unit& u, int wr, int wc, int fr, int fq, const Pre& pre) const {
#pragma unroll
        for (int ai = 0; ai < 2; ++ai)
#pragma unroll
            for (int m = 0; m < 4; ++m) {
                const float rs = rstd_from(pre.s[ai * 4 + m]);
                float mx = -3.0e38f;
#pragma unroll
                for (int bj = 0; bj < 2; ++bj)
#pragma unroll
                    for (int n = 0; n < 2; ++n) { const f32x4 v = acc[ai][bj][m][n] * rs; acc[ai][bj][m][n] = v; mx = fmaxf(mx, fmaxf(fmaxf(v[0], v[1]), fmaxf(v[2], v[3]))); }
                mx = fmaxf(mx, __shfl_xor(mx, 16)); mx = fmaxf(mx, __shfl_xor(mx, 32));
                float sm = 0.f;
#pragma unroll
                for (int bj = 0; bj < 2; ++bj)
#pragma unroll
                    for (int n = 0; n < 2; ++n) { f32x4 v = acc[ai][bj][m][n];
#pragma unroll
                        for (int j = 0; j < 4; ++j) { v[j] = __builtin_amdgcn_exp2f((v[j] - mx) * L2E); sm += v[j]; }
                        acc[ai][bj][m][n] = v; }
                sm += __shfl_xor(sm, 16); sm += __shfl_xor(sm, 32);
                if (fq == 0) { const int r = ai * 128 + wr * 64 + m * 16 + fr; *(LAS f32x2*)(st + (r * 4 + wc) * 2) = (f32x2){mx, sm}; }
            }
        asm volatile("s_waitcnt lgkmcnt(0)" ::: "memory"); __builtin_amdgcn_s_barrier(); asm volatile("" ::: "memory");
        const int row0 = u.pm * 256 + wr * 64 + fr, col0 = u.pn * 256 + wc * 32 + 8 * fq;
#pragma unroll
        for (int ai = 0; ai < 2; ++ai)
#pragma unroll
            for (int m = 0; m < 4; ++m) {
                const int r = ai * 128 + wr * 64 + m * 16 + fr;
                const f32x4 s01 = *(const LAS f32x4*)(st + r * 8), s23 = *(const LAS f32x4*)(st + r * 8 + 4);
                const float M = fmaxf(fmaxf(s01[0], s01[2]), fmaxf(s23[0], s23[2]));
                const float L = s01[1] * __builtin_amdgcn_exp2f((s01[0] - M) * L2E) + s01[3] * __builtin_amdgcn_exp2f((s01[2] - M) * L2E)
                              + s23[1] * __builtin_amdgcn_exp2f((s23[0] - M) * L2E) + s23[3] * __builtin_amdgcn_exp2f((s23[2] - M) * L2E);
                const float mine = wc == 0 ? s01[0] : (wc == 1 ? s01[2] : (wc == 2 ? s23[0] : s23[2]));
                const float f = __builtin_amdgcn_exp2f((mine - M) * L2E) / L;
                bf16_t* rp = Pout + (size_t)u.pm * (XSP_1024 / 2) + (size_t)(row0 + ai * 128 + m * 16) * DM + col0;
#pragma unroll
                for (int bj = 0; bj < 2; ++bj) *(u32x4*)(rp + bj * 128) = pack8(acc[ai][bj][m][0] * f, acc[ai][bj][m][1] * f);
            }
    }
};

struct KVOrder {
    int G, c; const char* memn; const char* wt;
    int local, x, t;
    __device__ void fill(Unit& u, int seg, int pm, int pn) const {
        const char* lw = wt + (size_t)(seg >> 1) * LW; u.seg = seg; u.pm = pm; u.pn = pn;
        u.A = memn + (size_t)pm * 256 * 1024 * 2; u.B = lw + OFF_WK + (size_t)(seg & 1) * (OFF_WV - OFF_WK) + (size_t)pn * 256 * 1024 * 2;
    }
    __device__ bool next(int i, Unit& u) const {
        if (local) { if (i > 0 || t >= 16) return false; fill(u, t >> 2, x, t & 3); return true; }
        const int L = i * G + c; if (L >= 128) return false;
        fill(u, L >> 5, L & 7, (L & 31) >> 3); return true;
    }
};
struct PreOrder {
    int G, c; const char* wt; const char* kb; const char* vb;
    int local, x, t;
    __device__ void fill(Unit& u, int b, int uu) const {
        const int kind = uu >> 5, v = uu & 31, l = v >> 4, h = (v >> 2) & 3, j = v & 3; const char* lw = wt + (size_t)l * LW;
        u.seg = kind * 16 + l * 8 + b;
        if (kind == 0) { u.pm = h; u.pn = j; u.A = kb + ((size_t)l * 2048 * 1024 + (size_t)b * 256 * 1024 + h * 256) * 2; u.B = lw + OFF_WQ + ((size_t)j * 256 * 1024 + h * 256) * 2; }
        else { u.pm = j; u.pn = h; u.A = lw + OFF_WXO + ((size_t)j * 256 * 1024 + h * 256) * 2; u.B = vb + ((size_t)l * 2048 * 1024 + (size_t)b * 256 * 1024 + h * 256) * 2; }
    }
    __device__ bool next(int i, Unit& u) const {
        if (local) { if (i > 1) return false; fill(u, x, t + 32 * i); return true; }
        const int L = i * G + c; if (L >= 512) return false;
        fill(u, L >> 6, L & 63); return true;
    }
};
struct BranchOrder {
    pg8::StaticOrder so; const char* P; const char* W;
    __device__ bool next(int i, Unit& u) const {
        int pm, pn; if (!so.tile(i / 3, pm, pn)) return false; const int seg = i % 3;
        u.pm = pm; u.pn = pn; u.seg = seg;
        const int acol = seg == 0 ? 0 : (seg == 1 ? 1024 : 512);
        u.A = P + ((size_t)pm * 256 * INC + acol) * 2; u.B = W + (size_t)seg * (1024 * 512 * 2) + (size_t)pn * 256 * 512 * 2; return true;
    }
};
template <int MODE>
__device__ __forceinline__ void conv_weight(const float* W, int ldn, int K, int N, const float* kscale, float mul, bf16_t* WT, LAS float* scr, int gw, int NGW, int lane, int& off) {
    const int nblk = N / 32, nitems = (K / 64) * nblk;
    const int first = (gw + NGW - (off % NGW)) % NGW; off += nitems;
    for (int it = first; it < nitems; it += NGW) {
        const int kb = it / nblk, nb = it % nblk, k0 = 64 * kb, n0 = 32 * nb;
        float wv[32];
#pragma unroll
        for (int i = 0; i < 32; ++i) wv[i] = W[(size_t)(k0 + 2 * i + (lane >> 5)) * ldn + n0 + (lane & 31)];
#pragma unroll
        for (int i = 0; i < 32; ++i) { const int kk = 2 * i + (lane >> 5); const float sc = kscale ? kscale[k0 + kk] * mul : mul; scr[kk * 33 + (lane & 31)] = wv[i] * sc; }
        asm volatile("s_waitcnt lgkmcnt(0)" ::: "memory");
        const int c = lane & 7;
#pragma unroll
        for (int j = 0; j < 4; ++j) { const int n = (lane >> 3) + 8 * j; const LAS float* s = scr + (8 * c) * 33 + n;
            u32x4 o; o.x = pk2(s[0 * 33], s[1 * 33]); o.y = pk2(s[2 * 33], s[3 * 33]); o.z = pk2(s[4 * 33], s[5 * 33]); o.w = pk2(s[6 * 33], s[7 * 33]);
            int col = n0 + n, drow = col;
            if (MODE == 1) { const int isup = col >= FFH, hh = isup ? col - FFH : col; drow = 8 * (hh >> 2) + (hh & 3) + (isup ? 4 : 0); }
            if (MODE == 2) { if (col >= 1536 && col < 2560) { const int isx = col >= 2048, cc = isx ? col - 2048 : col - 1536; drow = 1536 + 8 * (cc >> 2) + (cc & 3) + (isx ? 4 : 0); } }
            *(u32x4*)(WT + (size_t)drow * K + k0 + 8 * c) = o; }
        asm volatile("s_waitcnt lgkmcnt(0)" ::: "memory");
    }
}

struct Args { const float* in[25]; float* out; unsigned char* ws; };

__device__ __forceinline__ void prologue(const Args& a, LAS unsigned char* lds, int wave_s) {
    const int tid_ = phase_tid(wave_s); const int tid = tid_, lane = tid & 63, wave = __builtin_amdgcn_readfirstlane(tid >> 6);
    unsigned char* ws = a.ws;
    LAS float* scr = (LAS float*)(lds + wave * 16384);
    const int gw = blockIdx.x * 8 + wave, NGW = gridDim.x * 8;
    const int gt = blockIdx.x * 512 + tid, NGT = gridDim.x * 512;
    int woff = 0;
    for (int l = 0; l < 2; ++l) {
        unsigned char* lw = ws + WS_WT + (size_t)l * LW;
        conv_weight<2>(a.in[3] + (size_t)l * DM * INC, INC, DM, INC, a.in[2] + l * DM, 1.f, (bf16_t*)(lw + OFF_WIN), scr, gw, NGW, lane, woff);
        conv_weight<0>(a.in[12] + (size_t)l * 512 * DM, DM, 512, DM, nullptr, 1.f, (bf16_t*)(lw + OFF_WA), scr, gw, NGW, lane, woff);
        conv_weight<0>(a.in[13] + (size_t)l * 512 * DM, DM, 512, DM, nullptr, 1.f, (bf16_t*)(lw + OFF_WA + 1 * MiB), scr, gw, NGW, lane, woff);
        conv_weight<0>(a.in[14] + (size_t)l * 512 * DM, DM, 512, DM, nullptr, 1.f, (bf16_t*)(lw + OFF_WA + 2 * MiB), scr, gw, NGW, lane, woff);
        conv_weight<0>(a.in[15] + (size_t)l * DM * DM, DM, DM, DM, nullptr, 1.f, (bf16_t*)(lw + OFF_WO), scr, gw, NGW, lane, woff);
        { const float* wq = a.in[18] + (size_t)l * DM * DM; const float* gq = a.in[16] + l * DM; bf16_t* dq = (bf16_t*)(lw + OFF_WQ);
          for (int e = gt * 4; e < DM * DM; e += NGT * 4) { const f32x4 v = *(const f32x4*)(wq + e); const float sc = gq[e >> 10] * 0.0625f; u32x2 w; w.x = cvt_pk_bf16(v[0] * sc, v[1] * sc); w.y = cvt_pk_bf16(v[2] * sc, v[3] * sc); *(u32x2*)(dq + e) = w; } }
        conv_weight<0>(a.in[19] + (size_t)l * DM * 2048, 2048, DM, DM, a.in[17] + l * DM, 1.f, (bf16_t*)(lw + OFF_WK), scr, gw, NGW, lane, woff);
        conv_weight<0>(a.in[19] + (size_t)l * DM * 2048 + 1024, 2048, DM, DM, a.in[17] + l * DM, 1.f, (bf16_t*)(lw + OFF_WV), scr, gw, NGW, lane, woff);
        conv_weight<0>(a.in[20] + (size_t)l * DM * DM, DM, DM, DM, nullptr, 1.f, (bf16_t*)(lw + OFF_WXO), scr, gw, NGW, lane, woff);
        conv_weight<1>(a.in[22] + (size_t)l * DM * 2 * FFH, 2 * FFH, DM, 2 * FFH, a.in[21] + l * DM, 1.f, (bf16_t*)(lw + OFF_WFI), scr, gw, NGW, lane, woff);
        conv_weight<0>(a.in[23] + (size_t)l * FFH * DM, DM, FFH, DM, nullptr, 1.f, (bf16_t*)(lw + OFF_WFO), scr, gw, NGW, lane, woff);
        bf16_t* wsd = (bf16_t*)(lw + OFF_WS); bf16_t* wgd = (bf16_t*)(lw + OFF_WG);
        const float* aws = a.in[7] + (size_t)l * 65536; const float* cwg = a.in[10] + (size_t)l * 65536; const float* csc = a.in[11] + l * 512;
        for (int e = gt; e < 65536; e += NGT) {
            const int i = (e >> 7) & 127, j = e & 127; wsd[e] = (bf16_t)f2bf(j <= i ? aws[e] : 0.f);
            const int gi = e >> 14, d = (e >> 7) & 127, c = e & 127; wgd[e] = (bf16_t)f2bf(cwg[(gi * 128 + c) * 128 + d] * csc[gi * 128 + d]);
        }
    }
    bf16_t* XB = (bf16_t*)(ws + WS_XB); float* ssq = (float*)(ws + WS_SSQ);
    for (int r = gw; r < MTOK; r += 2 * NGW) {
        const int r2 = r + NGW; const bool has2 = r2 < MTOK;
        const f32x4* xr = (const f32x4*)(a.in[0] + (size_t)r * DM) + lane; const f32x4* xr2 = (const f32x4*)(a.in[0] + (size_t)(has2 ? r2 : r) * DM) + lane;
        f32x4 v[4], v2[4]; float s = 0.f, s2 = 0.f;
#pragma unroll
        for (int j = 0; j < 4; ++j) { v[j] = xr[64 * j]; v2[j] = xr2[64 * j]; }
#pragma unroll
        for (int j = 0; j < 4; ++j) { s += (v[j][0] * v[j][0] + v[j][1] * v[j][1]) + (v[j][2] * v[j][2] + v[j][3] * v[j][3]); s2 += (v2[j][0] * v2[j][0] + v2[j][1] * v2[j][1]) + (v2[j][2] * v2[j][2] + v2[j][3] * v2[j][3]); }
        s = wave_sum(s); s2 = wave_sum(s2);
        u32x2* o = (u32x2*)(XB + (size_t)r * DM) + lane;
#pragma unroll
        for (int j = 0; j < 4; ++j) { u32x2 w; w.x = cvt_pk_bf16(v[j][0], v[j][1]); w.y = cvt_pk_bf16(v[j][2], v[j][3]); o[64 * j] = w; }
        if (lane < 4) ssq[(size_t)r * 4 + lane] = lane == 0 ? s : 0.f;
        if (has2) {
            u32x2* o2 = (u32x2*)(XB + (size_t)r2 * DM) + lane;
#pragma unroll
            for (int j = 0; j < 4; ++j) { u32x2 w; w.x = cvt_pk_bf16(v2[j][0], v2[j][1]); w.y = cvt_pk_bf16(v2[j][2], v2[j][3]); o2[64 * j] = w; }
            if (lane < 4) ssq[(size_t)r2 * 4 + lane] = lane == 0 ? s2 : 0.f;
        }
    }
    bf16_t* MN = (bf16_t*)(ws + WS_MEMN);
    for (int r = gw; r < MEMROWS; r += NGW) {
        const f32x4* xr = (const f32x4*)(a.in[1] + (size_t)r * DM) + lane; f32x4 v[4]; float s = 0.f;
#pragma unroll
        for (int j = 0; j < 4; ++j) { v[j] = xr[64 * j]; s += (v[j][0] * v[j][0] + v[j][1] * v[j][1]) + (v[j][2] * v[j][2] + v[j][3] * v[j][3]); }
        s = wave_sum(s); const float rs = __builtin_amdgcn_rsqf(s * (1.0f / 1024.0f) + EPSV);
        u32x2* o = (u32x2*)(MN + (size_t)r * DM) + lane;
#pragma unroll
        for (int j = 0; j < 4; ++j) { u32x2 w; w.x = cvt_pk_bf16(v[j][0] * rs, v[j][1] * rs); w.y = cvt_pk_bf16(v[j][2] * rs, v[j][3] * rs); o[64 * j] = w; }
    }
}

__device__ __forceinline__ void mixer_phase(LAS unsigned char* lds, bf16_t* P, const bf16_t* Wtril, const bf16_t* WgT, const float* ln_g, const float* ln_b,
                                            const float* a_bs, const float* bconv, int wave_s, int ch0, int chstep, int chend) {
    const int w = wave_s;
    LAS bf16_t* T = (LAS bf16_t*)lds;
    LAS bf16_t* Pp = (LAS bf16_t*)lds;
    for (int ch = ch0; ch < chend; ch += chstep) {
        const size_t row0 = (size_t)ch * 128; const int pos0 = (ch * 128) % SEQL;
        const int lane = phase_tid(0), fr = lane & 15, fq = lane >> 4;
        __syncthreads();
        {
            float lg[8], lb[8];
#pragma unroll
            for (int e = 0; e < 4; ++e) { lg[2 * e] = ln_g[128 * e + 2 * lane]; lg[2 * e + 1] = ln_g[128 * e + 2 * lane + 1]; lb[2 * e] = ln_b[128 * e + 2 * lane]; lb[2 * e + 1] = ln_b[128 * e + 2 * lane + 1]; }
#pragma unroll 1
            for (int jj = 0; jj < 16; jj += 16) {
                unsigned raw[16][4];
#pragma unroll
                for (int r = 0; r < 16; ++r)
#pragma unroll
                    for (int e = 0; e < 4; ++e) raw[r][e] = *(const unsigned*)(P + (row0 + 16 * w + jj + r) * INC + 512 + 128 * e + 2 * lane);
#pragma unroll
                for (int r = 0; r < 16; ++r) {
                    float v[8]; float s = 0.f, q = 0.f;
#pragma unroll
                    for (int e = 0; e < 4; ++e) { v[2 * e] = bf_lo(raw[r][e]); v[2 * e + 1] = bf_hi(raw[r][e]); s += v[2 * e] + v[2 * e + 1]; q += v[2 * e] * v[2 * e] + v[2 * e + 1] * v[2 * e + 1]; }
                    s = wave_sum(s); q = wave_sum(q);
                    const float mean = s * (1.0f / 512.0f), var = fmaxf(q * (1.0f / 512.0f) - mean * mean, 0.f), rstd = __builtin_amdgcn_rsqf(var + EPSV);
                    const int j = 16 * w + jj + r;
#pragma unroll
                    for (int e = 0; e < 4; ++e)
#pragma unroll
                        for (int h = 0; h < 2; ++h) T[(128 * e + 2 * lane + h) * 132 + j] = (bf16_t)f2bf((v[2 * e + h] - mean) * rstd * lg[2 * e + h] + lb[2 * e + h]);
                }
            }
        }
        {
            f32x4 w0a, w0b, w1a, w1b, w2a, w2b;
            { const f32x4* bc = (const f32x4*)(bconv + 8 * lane); w0a = bc[0]; w0b = bc[1]; w1a = bc[128]; w1b = bc[129]; w2a = bc[256]; w2b = bc[257]; }
            const size_t R = row0 + 16 * w; const int pos = pos0 + 16 * w;
            bf16_t* base = P + R * INC + 1024 + 8 * lane;
            f32x4 y1a = (f32x4){0.f, 0.f, 0.f, 0.f}, y1b = y1a, y2a = y1a, y2b = y1a;
            if (pos > 0) { unpack8(*(const u32x4*)(base - (size_t)INC + 512), y1a, y1b); unpack8(*(const u32x4*)(base - 2 * (size_t)INC + 512), y2a, y2b); }
#pragma unroll
            for (int t = 0; t < 16; ++t) {
                bf16_t* rp = base + (size_t)t * INC;
                f32x4 ga, gb, y0a, y0b;
                unpack8(*(const u32x4*)(rp), ga, gb); unpack8(*(const u32x4*)(rp + 512), y0a, y0b);
                const f32x4 oa = ga * (w0a * y2a + w1a * y1a + w2a * y0a), ob = gb * (w0b * y2b + w1b * y1b + w2b * y0b);
                *(u32x4*)(rp) = pack8(oa, ob);
                y2a = y1a; y2b = y1b; y1a = y0a; y1b = y0b;
            }
        }
        __syncthreads();
        {
#pragma unroll 1
            for (int g = 0; g < 4; ++g) {
                bf16x8 wf[4];
#pragma unroll
                for (int ks = 0; ks < 4; ++ks) wf[ks] = *(const bf16x8*)(Wtril + ((g * 128 + 16 * w + fr) * 128 + 32 * ks + 8 * fq));
                const float bsv = a_bs[g * 128 + 16 * w + fr];
                bf16_t* up = P + (row0 + 16 * w + fr) * INC + g * 128 + 4 * fq;
                u32x2 uv[8];
#pragma unroll
                for (int db = 0; db < 8; ++db) uv[db] = *(const u32x2*)(up + 16 * db);
#pragma unroll
                for (int db = 0; db < 8; ++db) {
                    f32x4 acc = (f32x4){0.f, 0.f, 0.f, 0.f};
#pragma unroll
                    for (int ks = 0; ks < 4; ++ks) {
                        const LAS u32x2* tp = (const LAS u32x2*)(T + (g * 128 + 16 * db + fr) * 132 + 32 * ks + 8 * fq);
                        const u32x2 t0 = tp[0], t1 = tp[1]; u32x4 tw; tw.x = t0.x; tw.y = t0.y; tw.z = t1.x; tw.w = t1.y;
                        acc = __builtin_amdgcn_mfma_f32_16x16x32_bf16(__builtin_bit_cast(bf16x8, tw), wf[ks], acc, 0, 0, 0);
                    }
                    u32x2 o; o.x = cvt_pk_bf16(bf_lo(uv[db].x) * (acc[0] + bsv), bf_hi(uv[db].x) * (acc[1] + bsv)); o.y = cvt_pk_bf16(bf_lo(uv[db].y) * (acc[2] + bsv), bf_hi(uv[db].y) * (acc[3] + bsv));
                    *(u32x2*)(up + 16 * db) = o;
                }
            }
        }
        __syncthreads();
        {
            const int lane_c = phase_tid(0);
            const int gi = lane_c >> 4, win = 2 << gi;
            const size_t R = row0 + 16 * w; const int pos = pos0 + 16 * w;
            const bf16_t* zc = P + R * INC + 2560 + 8 * lane_c;
            u32x4 oldr[16], ownr[16];
#pragma unroll
            for (int t = 0; t < 16; ++t) { const bool ok = (pos + t - win) >= 0; const long off = ok ? (long)(t - win) * INC : 0; oldr[t] = *(const u32x4*)(zc + off); if (!ok) oldr[t] = (u32x4){0u, 0u, 0u, 0u}; }
#pragma unroll
            for (int t = 0; t < 16; ++t) ownr[t] = *(const u32x4*)(zc + (size_t)t * INC);
            f32x4 Sa = (f32x4){0.f, 0.f, 0.f, 0.f}, Sb = Sa;
#pragma unroll
            for (int t = 0; t < 16; ++t) { f32x4 oa, ob; unpack8(oldr[t], oa, ob); if (t < win) { Sa += oa; Sb += ob; } }
#pragma unroll
            for (int t = 0; t < 16; ++t) {
                f32x4 za, zb, oa, ob; unpack8(ownr[t], za, zb); unpack8(oldr[t], oa, ob);
                Sa += za - oa; Sb += zb - ob;
                const int cnt = (pos + t + 1) < win ? (pos + t + 1) : win; const float ic = __builtin_amdgcn_rcpf((float)cnt);
                *(LAS u32x4*)(Pp + (16 * w + t) * 520 + 8 * lane_c) = pack8(Sa * ic - za, Sb * ic - zb);
            }
        }
        __syncthreads();
        {
#pragma unroll 1
            for (int gi = 0; gi < 4; ++gi) {
                bf16x8 pf[4];
#pragma unroll
                for (int ks = 0; ks < 4; ++ks) pf[ks] = *(const LAS bf16x8*)(Pp + (16 * w + fr) * 520 + gi * 128 + 32 * ks + 8 * fq);
#pragma unroll 8
                for (int db = 0; db < 8; ++db) {
                    f32x4 acc = (f32x4){0.f, 0.f, 0.f, 0.f};
#pragma unroll
                    for (int ks = 0; ks < 4; ++ks) {
                        const bf16x8 wfr = *(const bf16x8*)(WgT + ((gi * 128 + 16 * db + fr) * 128 + 32 * ks + 8 * fq));
                        acc = __builtin_amdgcn_mfma_f32_16x16x32_bf16(wfr, pf[ks], acc, 0, 0, 0);
                    }
                    u32x2 o; o.x = cvt_pk_bf16(acc[0], acc[1]); o.y = cvt_pk_bf16(acc[2], acc[3]);
                    *(u32x2*)(P + (row0 + 16 * w + fr) * INC + 512 + gi * 128 + 16 * db + 4 * fq) = o;
                }
            }
        }
    }
}

#define XB_TMO      128
#define XB_XCNT(j)  (256  + 64 * (j))
#define XB_XSUB(j)  (1280 + 64 * (j))
#define XB_XGEN(j)  (2304 + 64 * (j))
#define XB_TOP      3328
#define XB_TOPGEN   3392
#define XB_TEAM(j)  (3456 + 64 * (j))
#define XCD_BAR_WORDS (3456 + 64 * 64)
#define XB_SPIN_CAP (1u << 20)
__device__ __forceinline__ unsigned xb_ld(unsigned* p)              { return __hip_atomic_load(p, __ATOMIC_RELAXED, __HIP_MEMORY_SCOPE_AGENT); }
__device__ __forceinline__ unsigned xb_add(unsigned* p, unsigned v) { return __hip_atomic_fetch_add(p, v, __ATOMIC_RELAXED, __HIP_MEMORY_SCOPE_AGENT); }
__device__ __forceinline__ unsigned xb_xcc_id() { return (unsigned)__builtin_amdgcn_s_getreg((3 << 11) | 20) & 0xFu; }
#define XB_SPIN(cond, bar) do { unsigned _sp = 0; while (cond) { __builtin_amdgcn_s_sleep(1); \
    if ((++_sp & 255u) == 0u) { if (xb_ld(&(bar)[XB_TMO])) break; if (_sp > XB_SPIN_CAP) { atomicAdd(&(bar)[XB_TMO], 1u); break; } } } } while (0)
struct XcdBarrier { unsigned* bar; unsigned x; volatile LAS unsigned* st; };
__device__ __forceinline__ XcdBarrier xcd_barrier_post(unsigned* bar, volatile LAS unsigned* st, bool leader) {
    XcdBarrier b; b.bar = bar; b.x = xb_xcc_id(); b.st = st;
    if (leader) (void)xb_add(&bar[XB_XCNT(b.x)], 1u);
    return b;
}
__device__ __forceinline__ void xcd_barrier_complete(unsigned* bar, unsigned x, unsigned& nloc, unsigned& nx) {
    const unsigned G = gridDim.x * gridDim.y * gridDim.z;
    unsigned sum, cnt, mine, sp = 0u;
    for (;;) {
        sum = 0u; cnt = 0u; mine = 0u;
#pragma unroll
        for (unsigned j = 0; j < 16; ++j) { const unsigned c = xb_ld(&bar[XB_XCNT(j)]); sum += c; cnt += (c > 0u) ? 1u : 0u; mine = (j == x) ? c : mine; }
        if (sum == G) break;
        __builtin_amdgcn_s_sleep(1);
        if ((++sp & 255u) == 0u) { if (xb_ld(&bar[XB_TMO])) break; if (sp > XB_SPIN_CAP) { atomicAdd(&bar[XB_TMO], 1u); break; } }
    }
    nloc = mine > 0u ? mine : 1u; nx = cnt > 0u ? cnt : 1u;
}
__device__ __forceinline__ void xcd_barrier(const XcdBarrier& b, bool leader) {
    asm volatile("s_waitcnt vmcnt(0)" ::: "memory");
    __syncthreads();
    if (leader) {
        unsigned* bar = b.bar;
        __builtin_amdgcn_s_waitcnt(0);
        unsigned nloc = b.st[0], nx = b.st[1];
        if (nloc == 0u) { xcd_barrier_complete(bar, b.x, nloc, nx); b.st[0] = nloc; b.st[1] = nx; }
        const unsigned old = xb_add(&bar[XB_XSUB(b.x)], 1u);
        const unsigned gen = old / nloc;
        if (old + 1u == (gen + 1u) * nloc) {
            __builtin_amdgcn_fence(__ATOMIC_RELEASE, "agent");
            asm volatile("s_waitcnt vmcnt(0)" ::: "memory");
            const unsigned og = xb_add(&bar[XB_TOP], 1u);
            const unsigned tg = og / nx;
            if (og + 1u == (tg + 1u) * nx) xb_add(&bar[XB_TOPGEN], 1u);
            else XB_SPIN(xb_ld(&bar[XB_TOPGEN]) == tg, bar);
            __builtin_amdgcn_fence(__ATOMIC_ACQUIRE, "agent");
            xb_add(&bar[XB_XGEN(b.x)], 1u);
            asm volatile("s_waitcnt vmcnt(0)" ::: "memory");
        } else {
            XB_SPIN(xb_ld(&bar[XB_XGEN(b.x)]) == gen, bar);
            __builtin_amdgcn_fence(__ATOMIC_ACQUIRE, "agent");
            asm volatile("s_waitcnt vmcnt(0)" ::: "memory");
        }
    }
    __syncthreads();
}

__device__ __forceinline__ void xcc_local_barrier(unsigned* bar, unsigned widx, unsigned n, unsigned& epoch, bool leader) {
    asm volatile("s_waitcnt vmcnt(0)" ::: "memory");
    __syncthreads();
    if (leader) {
        __builtin_amdgcn_s_waitcnt(0);
        (void)xb_add(&bar[widx], 1u);
        const unsigned want = n * (epoch + 1u);
        XB_SPIN(xb_ld(&bar[widx]) < want, bar);
        __builtin_amdgcn_fence(__ATOMIC_ACQUIRE, "agent");
        asm volatile("s_waitcnt vmcnt(0)" ::: "memory");
    }
    ++epoch;
    __syncthreads();
}

__device__ __forceinline__ unsigned char* opaque_ptr(unsigned char* p) { asm volatile("" : "+s"(p)); return p; }
#define PHASE_PTRS() unsigned char* wsp = opaque_ptr(a.ws); (void)wsp; const char* lw = (const char*)(wsp + WS_WT + (size_t)l * LW); (void)lw; \
    bf16_t* XB = (bf16_t*)(wsp + WS_XB); (void)XB; float* ssq = (float*)(wsp + WS_SSQ); (void)ssq; bf16_t* PROJ = (bf16_t*)(wsp + WS_PROJ); (void)PROJ

__global__ void __launch_bounds__(512, 2) fwd_megakernel(Args a) {
    extern __shared__ __attribute__((aligned(16))) unsigned char lds_raw[];
    LAS unsigned char* lds = (LAS unsigned char*)lds_raw;
    cg::grid_group grid = cg::this_grid();
    const int G = gridDim.x;
    const int wave_s = __builtin_amdgcn_readfirstlane(threadIdx.x >> 6);

    const bool leader = (wave_s == 0) && (phase_tid(0) == 0);
    volatile LAS unsigned* bst = (volatile LAS unsigned*)(lds + LDS_MISC);
    const unsigned xcc = xb_xcc_id();
    if (leader) { bst[0] = 0u; bst[1] = 0u; bst[2] = xb_add((unsigned*)a.ws + XB_XCNT(xcc), 1u); }
    __syncthreads();
    XcdBarrier xbar; xbar.bar = (unsigned*)a.ws; xbar.x = xcc; xbar.st = bst;
    prologue(a, lds, wave_s);
    if (G == 256) xcd_barrier(xbar, leader); else CG_GRID_SYNC();
    if (leader) { unsigned ok = (G == 256) ? 1u : 0u;
#pragma unroll
        for (unsigned j2 = 0; j2 < 8; ++j2) ok &= (xb_ld((unsigned*)a.ws + XB_XCNT(j2)) == 32u) ? 1u : 0u;
        bst[3] = ok; }
    __syncthreads();
    const unsigned ticket = (unsigned)__builtin_amdgcn_readfirstlane((int)bst[2]);
    const bool local_ok = __builtin_amdgcn_readfirstlane((int)bst[3]) != 0;
    const int cidx = local_ok ? (int)(xcc + 8u * ticket) : (int)blockIdx.x;
    unsigned epoch_t = 0u;
    unsigned epoch = (G == 256) ? 1u : 0u;
    {
        unsigned char* wsp = opaque_ptr(a.ws);
        KVOrder S{G, cidx, (const char*)(wsp + WS_MEMN), (const char*)(wsp + WS_WT), local_ok ? 1 : 0, (int)xcc, (int)ticket};
        EpiKV E{(bf16_t*)(wsp + WS_KB), (bf16_t*)(wsp + WS_VT)};
        pg8::gemm_phase(lds, pg8::Gemm{1024, 1024, 1024}, S, E, wave_s);
    }
    GRID_SYNC();
    {
        unsigned char* wsp = opaque_ptr(a.ws);
        PreOrder S{G, cidx, (const char*)(wsp + WS_WT), (const char*)(wsp + WS_KB), (const char*)(wsp + WS_VT), local_ok ? 1 : 0, (int)xcc, (int)ticket};
        EpiPre E{(bf16_t*)a.out};
        pg8::gemm_phase(lds, pg8::Gemm{256, 1024, 1024}, S, E, wave_s);
    }
#pragma unroll 1
    for (int l = 0; l < 2; ++l) {
        {
            PHASE_PTRS();
            pg8::PlainOrder S; S.so.init(MTOK, INC, G, cidx); S.A = (const char*)XB; S.B = lw + OFF_WIN; S.astep = (size_t)256 * DM * 2; S.bstep = (size_t)256 * DM * 2; S.axs = 0;
            EpiInProj E{PROJ, ssq, a.in[4] + l * 3 * DM};
            pg8::gemm_phase(lds, pg8::Gemm{DM, DM, DM}, S, E, wave_s);
        }
        GRID_SYNC();
        {
            PHASE_PTRS();
            const int ch0 = local_ok ? (int)(64u * xcc + ticket) : (int)blockIdx.x, chstep = local_ok ? 32 : G, chend = local_ok ? (int)(64u * xcc + 64u) : MTOK / 128;
            mixer_phase(lds, PROJ, (const bf16_t*)(lw + OFF_WS), (const bf16_t*)(lw + OFF_WG), a.in[5] + l * 512, a.in[6] + l * 512, a.in[8] + l * 512, a.in[9] + l * 1536, wave_s, ch0, chstep, chend);
        }
        GRID_SYNC();
        {
            PHASE_PTRS();
            BranchOrder S; S.so.init(MTOK, DM, G, cidx); S.P = (const char*)PROJ; S.W = lw + OFF_WA;
            EpiBranch E{PROJ};
            pg8::gemm_phase(lds, pg8::Gemm{512, INC, 512}, S, E, wave_s);
        }
        TEAM_SYNC();
        {
            PHASE_PTRS();
            pg8::PlainOrder S; S.so.init(MTOK, DM, G, cidx); S.A = (const char*)(PROJ + 1536); S.B = lw + OFF_WO; S.astep = (size_t)256 * INC * 2; S.bstep = (size_t)256 * DM * 2; S.axs = 0;
            EpiResid E{XB, ssq, (LAS float*)(lds + LDS_STAT)};
            pg8::gemm_phase(lds, pg8::Gemm{DM, INC, DM}, S, E, wave_s);
        }
        TEAM_SYNC();
        {
            PHASE_PTRS();
            pg8::PlainOrder S; S.so.init(MTOK, DM, G, cidx); S.A = (const char*)XB; S.B = (const char*)a.out + (size_t)l * 2 * MiB; S.astep = (size_t)256 * DM * 2; S.bstep = (size_t)256 * DM * 2; S.axs = 0; S.bxs = 32 * MiB;
            EpiSoftmax E{(bf16_t*)(wsp + WS_PROJ + PJ_P), (LAS float*)(lds + LDS_STAT), ssq};
            pg8::gemm_phase(lds, pg8::Gemm{DM, DM, DM}, S, E, wave_s);
        }
        TEAM_SYNC();
        {
            PHASE_PTRS();
            pg8::PlainOrder S; S.so.init(MTOK, DM, G, cidx); S.A = (const char*)(wsp + WS_PROJ + PJ_P); S.B = (const char*)a.out + 4 * MiB + (size_t)l * 2 * MiB; S.astep = (size_t)256 * DM * 2; S.bstep = (size_t)256 * DM * 2; S.axs = XSP_1024; S.bxs = 32 * MiB;
            EpiResid E{XB, ssq, (LAS float*)(lds + LDS_STAT)};
            pg8::gemm_phase(lds, pg8::Gemm{DM, DM, DM}, S, E, wave_s);
        }
        TEAM_SYNC();
        {
            PHASE_PTRS();
            pg8::PlainOrder S; S.so.init(MTOK, 2 * FFH, G, cidx); S.A = (const char*)XB; S.B = lw + OFF_WFI; S.astep = (size_t)256 * DM * 2; S.bstep = (size_t)256 * DM * 2; S.axs = 0;
            EpiSwiglu E{(bf16_t*)(wsp + WS_PROJ + PJ_H), ssq};
            pg8::gemm_phase(lds, pg8::Gemm{DM, DM, DM}, S, E, wave_s);
        }
        TEAM_SYNC();
        {
            PHASE_PTRS();
            pg8::PlainOrder S; S.so.init(MTOK, DM, G, cidx); S.A = (const char*)(wsp + WS_PROJ + PJ_H); S.B = lw + OFF_WFO; S.astep = (size_t)256 * FFH * 2; S.bstep = (size_t)256 * FFH * 2; S.axs = XSP_FFH;
            EpiResid E{XB, ssq, (LAS float*)(lds + LDS_STAT)};
            pg8::gemm_phase(lds, pg8::Gemm{FFH, FFH, FFH}, S, E, wave_s);
        }
        if (l == 1) GRID_SYNC(); else TEAM_SYNC();
    }
    {
        const int l = 0; PHASE_PTRS();
        const int lane = phase_tid(0), wave = wave_s;
        const float* gf = a.in[24];
        f32x4 g0[2], g1[2];
#pragma unroll
        for (int e = 0; e < 2; ++e) { g0[e] = *(const f32x4*)(gf + 512 * e + 8 * lane); g1[e] = *(const f32x4*)(gf + 512 * e + 8 * lane + 4); }
        const int r0 = local_ok ? (int)(8192u * xcc + 8u * ticket) + wave : (int)blockIdx.x * 8 + wave, rstep = local_ok ? 256 : G * 8, rend = local_ok ? (int)(8192u * xcc + 8192u) : MTOK;
        for (int r = r0; r < rend; r += rstep) {
            float s = (lane < 4) ? ssq[(size_t)r * 4 + lane] : 0.f; s = wave_sum(s);
            const float rs = __builtin_amdgcn_rsqf(s * (1.0f / 1024.0f) + EPSV);
#pragma unroll
            for (int e = 0; e < 2; ++e) {
                f32x4 x0, x1; unpack8(*(const u32x4*)(XB + (size_t)r * DM + 512 * e + 8 * lane), x0, x1);
                float* op = a.out + (size_t)r * DM + 512 * e + 8 * lane;
                *(f32x4*)op = x0 * rs * g0[e]; *(f32x4*)(op + 4) = x1 * rs * g1[e];
            }
        }
    }
}

extern "C" void kernel_launch(void* const* d_in, const int* in_sizes, int n_in, void* d_out, int out_size, void* d_ws, size_t ws_size, hipStream_t stream) {
    static int grid = 0;
    if (grid == 0) {
        if (n_in != 25 || in_sizes[0] != MTOK * DM || out_size != MTOK * DM || ws_size < WS_END) {
            fprintf(stderr, "kernel_launch: unexpected shapes (n_in %d, in0 %d, out %d, ws %zu < %zu); nothing launched\n", n_in, n_in > 0 ? in_sizes[0] : -1, out_size, ws_size, (size_t)WS_END); grid = -1; return; }
        int dev = 0, cus = 0, per_cu = 0;
        hipGetDevice(&dev); hipDeviceGetAttribute(&cus, hipDeviceAttributeMultiprocessorCount, dev);
        if (hipFuncSetAttribute((const void*)fwd_megakernel, hipFuncAttributeMaxDynamicSharedMemorySize, LDS_BYTES) != hipSuccess) { fprintf(stderr, "kernel_launch: hipFuncSetAttribute failed\n"); grid = -1; return; }
        if (hipOccupancyMaxActiveBlocksPerMultiprocessor(&per_cu, (const void*)fwd_megakernel, 512, LDS_BYTES) != hipSuccess || per_cu < 1) { fprintf(stderr, "kernel_launch: occupancy query says %d blocks per CU\n", per_cu); per_cu = 1; }
        (void)hipGetLastError();
        grid = cus * per_cu;
    }
    if (grid < 0) return;
    if (hipMemsetAsync(d_ws, 0, XCD_BAR_WORDS * 4, stream) != hipSuccess) { fprintf(stderr, "kernel_launch: hipMemsetAsync failed\n"); return; }
    Args a{};
    for (int i = 0; i < 25; ++i) a.in[i] = (const float*)d_in[i];
    a.out = (float*)d_out; a.ws = (unsigned char*)d_ws;
    void* args[] = {&a};
    hipError_t e = hipLaunchCooperativeKernel((const void*)fwd_megakernel, dim3(grid), dim3(512), args, LDS_BYTES, stream);
    if (e != hipSuccess) fprintf(stderr, "kernel_launch: cooperative launch failed: %s (grid %d)\n", hipGetErrorString(e), grid);
}
```

```cpp
#include <hip/hip_runtime.h>
#include <hip/hip_cooperative_groups.h>
#include <cstdio>
#include <cstdint>
namespace cg = cooperative_groups;

#define LAS __attribute__((address_space(3)))
typedef unsigned short bf16_t;
typedef short bf16x8 __attribute__((ext_vector_type(8)));
typedef float f32x4 __attribute__((ext_vector_type(4)));
typedef float f32x2 __attribute__((ext_vector_type(2)));
typedef unsigned u32x4 __attribute__((ext_vector_type(4)));
typedef unsigned u32x2 __attribute__((ext_vector_type(2)));

constexpr int MTOK = 65536, DM = 1024, INC = 6144, FFH = 2816, SEQL = 8192, MEMROWS = 2048;
constexpr float EPSV = 1e-6f;
constexpr float L2E = 1.4426950408889634f;
constexpr size_t MiB = 1u << 20;
constexpr size_t WS_WT = 1 * MiB, LW = 42 * MiB;
constexpr size_t OFF_WIN = 0, OFF_WA = 12 * MiB, OFF_WO = 15 * MiB, OFF_WQ = 17 * MiB, OFF_WK = 19 * MiB, OFF_WV = 21 * MiB, OFF_WXO = 23 * MiB,
                 OFF_WFI = 25 * MiB, OFF_WFO = 36 * MiB, OFF_WS = 41 * MiB + 512 * 1024, OFF_WG = OFF_WS + 128 * 1024;
constexpr size_t WS_KB = WS_WT + 2 * LW;
constexpr size_t WS_VT = WS_KB + 8 * MiB;
constexpr size_t WS_MEMN = WS_VT + 8 * MiB;
constexpr size_t WS_SSQ = WS_MEMN + 4 * MiB;
constexpr size_t WS_XB = WS_SSQ + 4 * MiB;
constexpr size_t WS_PROJ = WS_XB + 128 * MiB;
constexpr size_t WS_END = WS_PROJ + 768 * MiB;
constexpr size_t PJ_P = 0, PJ_H = 1 * MiB;
constexpr size_t XSP_1024 = 3 * MiB - (size_t)256 * 1024 * 2, XSP_FFH = 3 * MiB - (size_t)256 * FFH * 2;
constexpr int LDS_BYTES = 147456;
constexpr int LDS_MISC = 131072 + 8192;
constexpr int LDS_STAT = 131072;

typedef __bf16 bf16x2_t __attribute__((ext_vector_type(2)));
__device__ __forceinline__ unsigned cvt_pk_bf16(float lo, float hi) { const bf16x2_t r = __builtin_convertvector((f32x2){lo, hi}, bf16x2_t); return __builtin_bit_cast(unsigned, r); }
__device__ __forceinline__ unsigned f2bf(float f) { unsigned u = __builtin_bit_cast(unsigned, f); return (u + 0x7fffu + ((u >> 16) & 1u)) >> 16; }
__device__ __forceinline__ unsigned pk2(float lo, float hi) { return f2bf(lo) | (f2bf(hi) << 16); }
__device__ __forceinline__ float bf_lo(unsigned u) { return __builtin_bit_cast(float, u << 16); }
__device__ __forceinline__ float bf_hi(unsigned u) { return __builtin_bit_cast(float, u & 0xffff0000u); }
__device__ __forceinline__ void unpack8(const u32x4 w, f32x4& a, f32x4& b) { a = (f32x4){bf_lo(w.x), bf_hi(w.x), bf_lo(w.y), bf_hi(w.y)}; b = (f32x4){bf_lo(w.z), bf_hi(w.z), bf_lo(w.w), bf_hi(w.w)}; }
__device__ __forceinline__ u32x4 pack8(const f32x4 a, const f32x4 b) { u32x4 w; w.x = cvt_pk_bf16(a[0], a[1]); w.y = cvt_pk_bf16(a[2], a[3]); w.z = cvt_pk_bf16(b[0], b[1]); w.w = cvt_pk_bf16(b[2], b[3]); return w; }
__device__ __forceinline__ int phase_tid(int wave_s) { int lane; asm volatile("v_mbcnt_lo_u32_b32 %0, -1, 0\n\tv_mbcnt_hi_u32_b32 %0, -1, %0" : "=v"(lane)); return wave_s * 64 + lane; }
__device__ __forceinline__ float wave_sum(float v) {
#pragma unroll
    for (int o = 1; o < 64; o <<= 1) v += __shfl_xor(v, o);
    return v;
}
__device__ __forceinline__ float fast_sigmoid(float x) { return __builtin_amdgcn_rcpf(1.0f + __builtin_amdgcn_exp2f(-x * L2E)); }
#define ROWFENCE() asm volatile("" ::: "memory")
#define GRID_SYNC() do { if (local_ok) xcc_local_barrier((unsigned*)a.ws, XB_XSUB(xcc), 32u, epoch, leader); else xcd_barrier(xbar, leader); } while (0)
#define TEAM_SYNC() do { if (local_ok) xcc_local_barrier((unsigned*)a.ws, XB_TEAM(8u * xcc + (ticket & 7u)), 4u, epoch_t, leader); else xcd_barrier(xbar, leader); } while (0)
#define CG_GRID_SYNC() do { asm volatile("s_waitcnt vmcnt(0) lgkmcnt(0)" ::: "memory"); grid.sync(); __builtin_amdgcn_fence(__ATOMIC_ACQUIRE, "agent"); asm volatile("s_waitcnt vmcnt(0)" ::: "memory"); } while (0)

namespace pg8 {
constexpr int BM = 256, BK = 64, HALF = 128, HTB = HALF * BK * 2, STAGE_BYTES = 8 * HTB, NXCD = 8, WGM = 8;
__host__ __device__ __forceinline__ int lds_byte(int r, int c) { const int st = (r >> 4) * 2 + (c >> 5), rr = r & 15, cc = c & 31, ob = rr * 64 + cc * 2; return st * 1024 + (ob ^ (((ob >> 9) & 1) << 5)); }
__host__ __device__ __forceinline__ void stage_rc(int b, int& R, int& C) { const int st = b / 1024, sb = b % 1024, swz = sb ^ (((sb >> 9) & 1) << 5); R = (st >> 1) * 16 + swz / 64; C = (st & 1) * 32 + (swz % 64) / 2; }
__host__ __device__ __forceinline__ int perm32(int rho) { const int n = rho >> 4, i = rho & 15; return 8 * (i >> 2) + 4 * n + (i & 3); }

struct Unit { int pm, pn, seg; const char* A; const char* B; };
struct Gemm { int K, lda, ldb; };

struct StaticOrder {
    int nM, nN, nwg, G, c;
    __device__ void init(int M, int N, int G_, int c_) { nM = M / BM; nN = N / BM; nwg = nM * nN; G = G_; c = c_; }
    __device__ bool tile(int i, int& pm, int& pn) const {
        const long L = (long)i * G + c; if (L >= nwg) return false;
        int wgid = (int)L; { const int q = nwg / NXCD, r = nwg % NXCD, xcd = wgid % NXCD, off = wgid / NXCD; wgid = (xcd < r ? xcd * (q + 1) : r * (q + 1) + (xcd - r) * q) + off; }
        const int nig = WGM * nN, gid = wgid / nig, fm = gid * WGM, gsz = (nM - fm) < WGM ? (nM - fm) : WGM;
        pm = fm + ((wgid % nig) % gsz); pn = (wgid % nig) / gsz; return true;
    }
};
struct PlainOrder {
    StaticOrder so; const char* A; const char* B; size_t astep, bstep, axs, bxs = 0;
    __device__ bool next(int i, Unit& u) const { int pm, pn; if (!so.tile(i, pm, pn)) return false; u.pm = pm; u.pn = pn; u.seg = 0; u.A = A + (size_t)pm * (astep + axs); u.B = B + (size_t)pn * bstep + (size_t)(pm >> 5) * bxs; return true; }
};

template <class Epi, class Sched>
__device__ __forceinline__ void gemm_phase(LAS unsigned char* lds, const Gemm g, const Sched& S, const Epi& E, int wave_s) {
    const int tid_ = phase_tid(wave_s);
    const int tid = tid_, wid = __builtin_amdgcn_readfirstlane(tid >> 6), lane = tid & 63, wr = wid >> 2, wc = wid & 3, fr = lane & 15, fq = lane >> 4;
    const int K = g.K, nt = K / BK;
    unsigned voffA[2], voffB[2];
#pragma unroll
    for (int i = 0; i < 2; ++i) { int R, C; stage_rc(tid * 16 + i * 8192, R, C); const int Rb = Epi::PERM ? ((R & ~31) + perm32(R & 31)) : R;
        voffA[i] = (unsigned)(R * g.lda + C) * 2u; voffB[i] = (unsigned)(Rb * g.ldb + C) * 2u; }
    const size_t kstep = (size_t)(BK * 2);
    const size_t hstepA = (size_t)HALF * g.lda * 2, hstepB = (size_t)HALF * g.ldb * 2;
    const unsigned ldsw = (unsigned)wid * 1024u;
    const int aoff = lds_byte(wr * 64 + fr, fq * 8), boff = lds_byte(wc * 32 + fr, fq * 8);
#define PG8_SA(b, h) (((b) * 2 + (h)) * HTB)
#define PG8_SB(b, h) ((4 + (b) * 2 + (h)) * HTB)
#define PG8_STAGE(bufoff, gbase, voff) do { _Pragma("unroll") for (int _i = 0; _i < 2; ++_i) \
        __builtin_amdgcn_global_load_lds((const unsigned*)((const char*)(gbase) + (voff)[_i]), (LAS unsigned*)(lds + (bufoff) + ldsw + _i * 8192), 16, 0, 0); } while (0)
#define PG8_LDA(dst, b, h) do { _Pragma("unroll") for (int m = 0; m < 4; ++m) _Pragma("unroll") for (int k = 0; k < 2; ++k) dst[m][k] = *(const LAS bf16x8*)(lds + PG8_SA(b, h) + aoff + m * 2048 + k * 1024); } while (0)
#define PG8_LDB(dst, b, h) do { _Pragma("unroll") for (int n = 0; n < 2; ++n) _Pragma("unroll") for (int k = 0; k < 2; ++k) dst[n][k] = *(const LAS bf16x8*)(lds + PG8_SB(b, h) + boff + n * 2048 + k * 1024); } while (0)
#define PG8_MMA(ai, bj, At, Bt) do { __builtin_amdgcn_s_setprio(1); _Pragma("unroll") for (int m = 0; m < 4; ++m) _Pragma("unroll") for (int n = 0; n < 2; ++n) _Pragma("unroll") for (int k = 0; k < 2; ++k) \
        acc[ai][bj][m][n] = __builtin_amdgcn_mfma_f32_16x16x32_bf16(Bt[n][k], At[m][k], acc[ai][bj][m][n], 0, 0, 0); __builtin_amdgcn_s_setprio(0); } while (0)
#define PG8_WAIT_V(n) asm volatile("s_waitcnt vmcnt(" #n ")" ::: "memory")
#define PG8_WAIT_L(n) asm volatile("s_waitcnt lgkmcnt(" #n ")" ::: "memory")
#define PG8_BAR __builtin_amdgcn_s_barrier()
#define PG8_SCHED __builtin_amdgcn_sched_barrier(0)
    Unit cur, nxt; int ui = 0;
    if (!S.next(0, cur)) return;
    f32x4 acc[2][2][4][2];
    if constexpr (Epi::INIT) E.first_init(acc, cur, wr, wc, fr, fq);
    else {
#pragma unroll
    for (int a = 0; a < 2; ++a)
#pragma unroll
        for (int b = 0; b < 2; ++b)
#pragma unroll
            for (int m = 0; m < 4; ++m)
#pragma unroll
                for (int n = 0; n < 2; ++n) acc[a][b][m][n] = (f32x4){0.f, 0.f, 0.f, 0.f};
    }
    bf16x8 At[4][2], B0[2][2], B1[2][2];
    const char* cA = cur.A; const char* cB = cur.B;
    typename Epi::Pre pre; E.prefetch(pre, cur, wr, fr, fq);
    PG8_STAGE(PG8_SB(0, 0), cB, voffB); PG8_STAGE(PG8_SB(0, 1), cB + hstepB, voffB); PG8_STAGE(PG8_SA(0, 0), cA, voffA); PG8_STAGE(PG8_SA(0, 1), cA + hstepA, voffA);
    if (wr == 1) PG8_BAR;
    PG8_WAIT_V(2); PG8_BAR;
    PG8_STAGE(PG8_SB(1, 0), cB + kstep, voffB); PG8_STAGE(PG8_SA(1, 0), cA + kstep, voffA); PG8_STAGE(PG8_SB(1, 1), cB + hstepB + kstep, voffB);
    PG8_WAIT_V(6); PG8_BAR;
    for (;;) {
        const bool has_next = S.next(ui + 1, nxt);
        const char* nA = has_next ? nxt.A : cA; const char* nB = has_next ? nxt.B : cB;
#pragma unroll 1
        for (int t = 0; t < nt; t += 2) {
            const bool last = (t == nt - 2);
            const char* a1 = cA + (size_t)(t + 1) * kstep;
            const char* a2 = last ? nA : cA + (size_t)(t + 2) * kstep; const char* b2 = last ? nB : cB + (size_t)(t + 2) * kstep;
            const char* a3 = a2 + kstep; const char* b3 = b2 + kstep;
            PG8_LDB(B0, 0, 0); PG8_LDB(B1, 0, 1); PG8_SCHED; PG8_LDA(At, 0, 0); PG8_STAGE(PG8_SA(1, 1), a1 + hstepA, voffA);
            PG8_WAIT_V(8); PG8_WAIT_L(0); PG8_BAR; PG8_MMA(0, 0, At, B0); PG8_MMA(0, 1, At, B1); PG8_BAR; PG8_SCHED;
            PG8_LDA(At, 0, 1); PG8_STAGE(PG8_SB(0, 0), b2, voffB); PG8_STAGE(PG8_SB(0, 1), b2 + hstepB, voffB); PG8_STAGE(PG8_SA(0, 0), a2, voffA);
            PG8_WAIT_V(8); PG8_WAIT_L(0); PG8_BAR; PG8_MMA(1, 0, At, B0); PG8_MMA(1, 1, At, B1); PG8_BAR; PG8_SCHED;
            PG8_LDB(B0, 1, 0); PG8_LDB(B1, 1, 1); PG8_SCHED; PG8_LDA(At, 1, 0); PG8_STAGE(PG8_SA(0, 1), a2 + hstepA, voffA);
            PG8_WAIT_V(8); PG8_WAIT_L(0); PG8_BAR; PG8_MMA(0, 0, At, B0); PG8_MMA(0, 1, At, B1); PG8_BAR; PG8_SCHED;
            PG8_LDA(At, 1, 1); PG8_STAGE(PG8_SB(1, 0), b3, voffB); PG8_STAGE(PG8_SB(1, 1), b3 + hstepB, voffB); PG8_STAGE(PG8_SA(1, 0), a3, voffA);
            PG8_WAIT_V(8); PG8_WAIT_L(0); PG8_BAR; PG8_MMA(1, 0, At, B0); PG8_MMA(1, 1, At, B1); PG8_BAR; PG8_SCHED;
        }
        if (wr == 0) PG8_BAR;
        typename Epi::Init itn;
        if constexpr (Epi::INIT) { if (has_next) E.load_init(itn, nxt, wr, wc, fr, fq); }
        E(acc, cur, wr, wc, fr, fq, pre);
        if (!has_next) break;
        if constexpr (Epi::INIT) E.apply_init(acc, itn, nxt, wr, wc, fr, fq);
        else if (!(Epi::MULTISEG && nxt.seg != 0)) {
#pragma unroll
            for (int a = 0; a < 2; ++a)
#pragma unroll
                for (int b = 0; b < 2; ++b)
#pragma unroll
                    for (int m = 0; m < 4; ++m)
#pragma unroll
                        for (int n = 0; n < 2; ++n) acc[a][b][m][n] = (f32x4){0.f, 0.f, 0.f, 0.f};
        }
        cur = nxt; cA = nA; cB = nB; ++ui;
        E.prefetch(pre, cur, wr, fr, fq);
        if (wr == 1) PG8_BAR;
    }
    PG8_WAIT_V(0);
    PG8_BAR;
#undef PG8_SA
#undef PG8_SB
#undef PG8_STAGE
#undef PG8_LDA
#undef PG8_LDB
#undef PG8_MMA
#undef PG8_WAIT_V
#undef PG8_WAIT_L
#undef PG8_BAR
#undef PG8_SCHED
}
}
using pg8::Unit;

__device__ __forceinline__ f32x2 gelu_pk(f32x2 v) {
    const f32x2 av = __builtin_elementwise_abs(v), d = av * 0.2316418882f + 1.0f;
    f32x2 t; t.x = __builtin_amdgcn_rcpf(d.x); t.y = __builtin_amdgcn_rcpf(d.y);
    f32x2 q = t * 0.5307027145f + (-0.7265760135f); q = q * t + 0.7107068705f; q = q * t + (-0.142248368f); q = q * t + 0.127414796f; q = q * t;
    const f32x2 s = (v * v) * (-0.72134752044f);
    f32x2 e; e.x = __builtin_amdgcn_exp2f(s.x); e.y = __builtin_amdgcn_exp2f(s.y);
    const f32x2 m = v * (q * e), r = v - m;
    f32x2 o; o.x = v.x < 0.f ? m.x : r.x; o.y = v.y < 0.f ? m.y : r.y; return o;
}
__device__ __forceinline__ f32x4 gelu4(f32x4 v) { const f32x2 a = gelu_pk((f32x2){v[0], v[1]}), b = gelu_pk((f32x2){v[2], v[3]}); return (f32x4){a.x, a.y, b.x, b.y}; }

struct NoPre { };
struct RowPre { float s[8]; };
__device__ __forceinline__ void load_rowpre(RowPre& p, const float* ssq, int pm, int wr, int fr, int fq) {
#pragma unroll
    for (int k = 0; k < 8; ++k) p.s[k] = ssq[(size_t)(pm * 256 + (k >> 2) * 128 + wr * 64 + (k & 3) * 16 + fr) * 4 + fq];
}
__device__ __forceinline__ float rstd_from(float s) { s += __shfl_xor(s, 16); s += __shfl_xor(s, 32); return __builtin_amdgcn_rsqf(s * (1.0f / 1024.0f) + EPSV); }
typedef f32x4 AccT[2][2][4][2];

struct EpiInProj {
    static constexpr bool PERM = true, MULTISEG = false;
    typedef RowPre Pre; __device__ __forceinline__ void prefetch(Pre& p, const Unit& u, int wr, int fr, int fq) const { load_rowpre(p, ssq, u.pm, wr, fr, fq); }
    static constexpr bool INIT = false; typedef NoPre Init;
    bf16_t* P; const float* ssq; const float* bgate;
    __device__ __forceinline__ void operator()(AccT& acc, const Unit& u, int wr, int wc, int fr, int fq, const Pre& pre) const {
        const int row0 = u.pm * 256 + wr * 64 + fr, col0 = u.pn * 256 + wc * 32 + 8 * fq;
        const int mode = u.pn < 4 ? 0 : (u.pn < 6 ? 1 : (u.pn < 10 ? 3 : (u.pn < 12 ? 1 : 2)));
        f32x4 bv[2][2];
#pragma unroll
        for (int bj = 0; bj < 2; ++bj)
#pragma unroll
            for (int n = 0; n < 2; ++n) bv[bj][n] = (mode == 2) ? *(const f32x4*)(bgate + (col0 - 3072) + bj * 128 + 4 * n) : (f32x4){0.f, 0.f, 0.f, 0.f};
#pragma unroll
        for (int ai = 0; ai < 2; ++ai)
#pragma unroll
            for (int m = 0; m < 4; ++m) {
                const int row = row0 + ai * 128 + m * 16; const float rs = rstd_from(pre.s[ai * 4 + m]);
                bf16_t* rp = P + (size_t)row * INC + col0;
#pragma unroll
                for (int bj = 0; bj < 2; ++bj) {
                    f32x4 v0 = acc[ai][bj][m][0] * rs, v1 = acc[ai][bj][m][1] * rs;
                    if (mode == 0) { v0 = gelu4(v0); v1 = gelu4(v1); }
                    if (mode == 2) { v0 = v0 + bv[bj][0]; v1 = v1 + bv[bj][1];
#pragma unroll
                        for (int j = 0; j < 4; ++j) { v0[j] = fminf(__builtin_amdgcn_exp2f(-v0[j] * L2E), 1e30f); v1[j] = fminf(__builtin_amdgcn_exp2f(-v1[j] * L2E), 1e30f); } }
                    if (mode == 3) { const f32x4 y = v0 * v1; u32x2 w; w.x = cvt_pk_bf16(y[0], y[1]); w.y = cvt_pk_bf16(y[2], y[3]);
                        *(u32x2*)(P + (size_t)row * INC + 1536 + (u.pn - 6) * 128 + bj * 64 + wc * 16 + 4 * fq) = w; }
                    else *(u32x4*)(rp + bj * 128) = pack8(v0, v1);
                }
            }
    }
};
struct EpiKV {
    static constexpr bool PERM = true, MULTISEG = false;
    typedef NoPre Pre; __device__ __forceinline__ void prefetch(Pre&, const Unit&, int, int, int) const {}
    static constexpr bool INIT = false; typedef NoPre Init;
    bf16_t* KB; bf16_t* VT;
    __device__ __forceinline__ void operator()(AccT& acc, const Unit& u, int wr, int wc, int fr, int fq, const Pre& pre) const {
        const int l = u.seg >> 1, isv = u.seg & 1;
        bf16_t* O = KB + (size_t)isv * ((WS_VT - WS_KB) / 2) + (size_t)l * 2048 * 1024; const int ldc = 1024;
        const int row0 = u.pm * 256 + wr * 64 + fr, col0 = u.pn * 256 + wc * 32 + 8 * fq;
#pragma unroll
        for (int ai = 0; ai < 2; ++ai)
#pragma unroll
            for (int m = 0; m < 4; ++m) { bf16_t* rp = O + (size_t)(row0 + ai * 128 + m * 16) * ldc + col0;
#pragma unroll
                for (int bj = 0; bj < 2; ++bj) *(u32x4*)(rp + bj * 128) = pack8(acc[ai][bj][m][0], acc[ai][bj][m][1]); }
    }
};
struct EpiPre {
    static constexpr bool PERM = true, MULTISEG = false;
    typedef NoPre Pre; __device__ __forceinline__ void prefetch(Pre&, const Unit&, int, int, int) const {}
    static constexpr bool INIT = false; typedef NoPre Init;
    bf16_t* WQKT;
    __device__ __forceinline__ void operator()(AccT& acc, const Unit& u, int wr, int wc, int fr, int fq, const Pre& pre) const {
        bf16_t* O = WQKT + (size_t)(u.seg & 7) * ((size_t)16 * 1024 * 1024) + (size_t)(u.seg >> 4) * ((size_t)2 * 1024 * 1024) + (size_t)((u.seg >> 3) & 1) * 1024 * 1024;
        const int row0 = u.pm * 256 + wr * 64 + fr, col0 = u.pn * 256 + wc * 32 + 8 * fq;
#pragma unroll
        for (int ai = 0; ai < 2; ++ai)
#pragma unroll
            for (int m = 0; m < 4; ++m) { bf16_t* rp = O + (size_t)(row0 + ai * 128 + m * 16) * 1024 + col0;
#pragma unroll
                for (int bj = 0; bj < 2; ++bj) *(u32x4*)(rp + bj * 128) = pack8(acc[ai][bj][m][0], acc[ai][bj][m][1]); }
    }
};
struct EpiBranch {
    static constexpr bool PERM = true, MULTISEG = true;
    typedef NoPre Pre; __device__ __forceinline__ void prefetch(Pre&, const Unit&, int, int, int) const {}
    static constexpr bool INIT = false; typedef NoPre Init;
    bf16_t* P;
    __device__ __forceinline__ void operator()(AccT& acc, const Unit& u, int wr, int wc, int fr, int fq, const Pre& pre) const {
        const int row0 = u.pm * 256 + wr * 64 + fr, col0 = u.pn * 256 + wc * 32 + 8 * fq;
        const int seg = u.seg;
#pragma unroll
        for (int ai = 0; ai < 2; ++ai)
#pragma unroll
            for (int m = 0; m < 4; ++m) {
                bf16_t* rp = P + (size_t)(row0 + ai * 128 + m * 16) * INC + col0;
#pragma unroll
                for (int bj = 0; bj < 2; ++bj) {
                    f32x4 a0, a1; unpack8(*(const u32x4*)(rp + 3072 + seg * 1024 + bj * 128), a0, a1);
#pragma unroll
                    for (int j = 0; j < 4; ++j) { a0[j] = __builtin_amdgcn_rcpf(1.0f + a0[j]); a1[j] = __builtin_amdgcn_rcpf(1.0f + a1[j]); }
                    if (seg < 2) { f32x4 b0, b1; unpack8(*(const u32x4*)(rp + 4096 + seg * 1024 + bj * 128), b0, b1);
                        a0 *= (b0 + 1.0f); a1 *= (b1 + 1.0f); }
                    acc[ai][bj][m][0] *= a0; acc[ai][bj][m][1] *= a1;
                    if (seg == 2) *(u32x4*)(rp + 1536 + bj * 128) = pack8(acc[ai][bj][m][0], acc[ai][bj][m][1]);
                }
                if (m == 3) ROWFENCE();
            }
    }
};
struct EpiResid {
    static constexpr bool PERM = true, MULTISEG = false;
    typedef NoPre Pre; __device__ __forceinline__ void prefetch(Pre&, const Unit&, int, int, int) const {}
    static constexpr int NPRE = 2;
    static constexpr bool INIT = true; struct Init { u32x4 x[NPRE][2]; };
    bf16_t* X; float* ssq; LAS float* st;
    __device__ __forceinline__ const bf16_t* xptr(const Unit& u, int wr, int wc, int fr, int fq) const { return X + (size_t)(u.pm * 256 + wr * 64 + fr) * DM + u.pn * 256 + wc * 32 + 8 * fq; }
    __device__ __forceinline__ void load_init(Init& it, const Unit& u, int wr, int wc, int fr, int fq) const {
        const bf16_t* xp = xptr(u, wr, wc, fr, fq);
#pragma unroll
        for (int m = 0; m < NPRE; ++m)
#pragma unroll
            for (int bj = 0; bj < 2; ++bj) it.x[m][bj] = *(const u32x4*)(xp + (size_t)(m * 16) * DM + bj * 128);
    }
    __device__ __forceinline__ void apply_init(AccT& acc, const Init& it, const Unit& u, int wr, int wc, int fr, int fq) const {
        const bf16_t* xp = xptr(u, wr, wc, fr, fq);
#pragma unroll
        for (int m = 0; m < NPRE; ++m)
#pragma unroll
            for (int bj = 0; bj < 2; ++bj) unpack8(it.x[m][bj], acc[0][bj][m][0], acc[0][bj][m][1]);
#pragma unroll
        for (int k = NPRE; k < 8; ++k) { const int ai = k >> 2, m = k & 3;
#pragma unroll
            for (int bj = 0; bj < 2; ++bj) unpack8(*(const u32x4*)(xp + (size_t)(ai * 128 + m * 16) * DM + bj * 128), acc[ai][bj][m][0], acc[ai][bj][m][1]);
        }
    }
    __device__ __forceinline__ void first_init(AccT& acc, const Unit& u, int wr, int wc, int fr, int fq) const {
        const bf16_t* xp = xptr(u, wr, wc, fr, fq);
#pragma unroll
        for (int ai = 0; ai < 2; ++ai)
#pragma unroll
            for (int m = 0; m < 4; ++m) {
#pragma unroll
                for (int bj = 0; bj < 2; ++bj) unpack8(*(const u32x4*)(xp + (size_t)(ai * 128 + m * 16) * DM + bj * 128), acc[ai][bj][m][0], acc[ai][bj][m][1]);
                if (m & 1) ROWFENCE();
            }
    }
    __device__ __forceinline__ void operator()(AccT& acc, const Unit& u, int wr, int wc, int fr, int fq, const Pre& pre) const {
        const int row0 = u.pm * 256 + wr * 64 + fr, col0 = u.pn * 256 + wc * 32 + 8 * fq;
#pragma unroll
        for (int ai = 0; ai < 2; ++ai)
#pragma unroll
            for (int m = 0; m < 4; ++m) {
                const int row = row0 + ai * 128 + m * 16; bf16_t* rp = X + (size_t)row * DM + col0; float ss = 0.f;
#pragma unroll
                for (int bj = 0; bj < 2; ++bj) {
                    const f32x4 x0 = acc[ai][bj][m][0], x1 = acc[ai][bj][m][1];
                    ss += (x0[0] * x0[0] + x0[1] * x0[1]) + (x0[2] * x0[2] + x0[3] * x0[3]) + (x1[0] * x1[0] + x1[1] * x1[1]) + (x1[2] * x1[2] + x1[3] * x1[3]);
                    *(u32x4*)(rp + bj * 128) = pack8(x0, x1);
                }
                ss += __shfl_xor(ss, 16); ss += __shfl_xor(ss, 32);
                if (fq == 0) st[(ai * 128 + wr * 64 + m * 16 + fr) * 4 + wc] = ss;
            }
        asm volatile("s_waitcnt lgkmcnt(0)" ::: "memory"); __builtin_amdgcn_s_barrier(); asm volatile("" ::: "memory");
        const int t = (wr * 4 + wc) * 64 + fq * 16 + fr;
        if (t < 256) { const f32x4 p = *(const LAS f32x4*)(st + t * 4); ssq[(size_t)(u.pm * 256 + t) * 4 + u.pn] = (p[0] + p[1]) + (p[2] + p[3]); }
    }
};
struct EpiSwiglu {
    static constexpr bool PERM = true, MULTISEG = false;
    typedef RowPre Pre; __device__ __forceinline__ void prefetch(Pre& p, const Unit& u, int wr, int fr, int fq) const { load_rowpre(p, ssq, u.pm, wr, fr, fq); }
    static constexpr bool INIT = false; typedef NoPre Init;
    bf16_t* H; const float* ssq;
    __device__ __forceinline__ void operator()(AccT& acc, const Unit& u, int wr, int wc, int fr, int fq, const Pre& pre) const {
        const int row0 = u.pm * 256 + wr * 64 + fr, h0 = u.pn * 128 + wc * 16 + 4 * fq;
#pragma unroll
        for (int ai = 0; ai < 2; ++ai)
#pragma unroll
            for (int m = 0; m < 4; ++m) {
                const int row = row0 + ai * 128 + m * 16; const float rs = rstd_from(pre.s[ai * 4 + m]);
                bf16_t* rp = H + (size_t)u.pm * (XSP_FFH / 2) + (size_t)row * FFH + h0;
#pragma unroll
                for (int bj = 0; bj < 2; ++bj) {
                    const f32x4 gt = acc[ai][bj][m][0] * rs, up = acc[ai][bj][m][1] * rs; f32x4 o;
#pragma unroll
                    for (int j = 0; j < 4; ++j) o[j] = gt[j] * fast_sigmoid(gt[j]) * up[j];
                    u32x2 w; w.x = cvt_pk_bf16(o[0], o[1]); w.y = cvt_pk_bf16(o[2], o[3]);
                    *(u32x2*)(rp + bj * 64) = w;
                }
            }
    }
};
struct EpiSoftmax {
    static constexpr bool PERM = true, MULTISEG = false;
    typedef RowPre Pre; __device__ __forceinline__ void prefetch(Pre& p, const Unit& u, int wr, int fr, int fq) const { load_rowpre(p, ssq, u.pm, wr, fr, fq); }
    static constexpr bool INIT = false; typedef NoPre Init;
    bf16_t* Pout; LAS float* st; const float* ssq;
    __device__ __forceinline__ void operator()(AccT& acc, const Unit& u, int wr, int wc, int fr, int fq, const Pre& pre) const {
#pragma unroll
        for (int ai = 0; ai < 2; ++ai)
#pragma unroll
            for (int m = 0; m < 4; ++m) {
                const float rs = rstd_from(pre.s[ai * 4 + m]);
                float mx = -3.0e38f;
#pragma unroll
                for (int bj = 0; bj < 2; ++bj)
#pragma unroll
                    for (int n = 0; n < 2; ++n) { const f32x4 v = acc[ai][bj][m][n] * rs; acc[ai][bj][m][n] = v; mx = fmaxf(mx, fmaxf(fmaxf(v[0], v[1]), fmaxf(v[2], v[3]))); }
                mx = fmaxf(mx, __shfl_xor(mx, 16)); mx = fmaxf(mx, __shfl_xor(mx, 32));
                float sm = 0.f;
#pragma unroll
                for (int bj = 0; bj < 2; ++bj)
#pragma unroll
                    for (int n = 0; n < 2; ++n) { f32x4 v = acc[ai][bj][m][n];
#pragma unroll
                        for (int j = 0; j < 4; ++j) { v[j] = __builtin_amdgcn_exp2f((v[j] - mx) * L2E); sm += v[j]; }
                        acc[ai][bj][m][n] = v; }
                sm += __shfl_xor(sm, 16); sm += __shfl_xor(sm, 32);
                if (fq == 0) { const int r = ai * 128 + wr * 64 + m * 16 + fr; *(LAS f32x2*)(st + (r * 4 + wc) * 2) = (f32x2){mx, sm}; }
            }
        asm volatile("s_waitcnt lgkmcnt(0)" ::: "memory"); __builtin_amdgcn_s_barrier(); asm volatile("" ::: "memory");
        const int row0 = u.pm * 256 + wr * 64 + fr, col0 = u.pn * 256 + wc * 32 + 8 * fq;
#pragma unroll
        for (int ai = 0; ai < 2; ++ai)
#pragma unroll
            for (int m = 0; m < 4; ++m) {
                const int r = ai * 128 + wr * 64 + m * 16 + fr;
                const f32x4 s01 = *(const LAS f32x4*)(st + r * 8), s23 = *(const LAS f32x4*)(st + r * 8 + 4);
                const float M = fmaxf(fmaxf(s01[0], s01[2]), fmaxf(s23[0], s23[2]));
                const float L = s01[1] * __builtin_amdgcn_exp2f((s01[0] - M) * L2E) + s01[3] * __builtin_amdgcn_exp2f((s01[2] - M) * L2E)
                              + s23[1] * __builtin_amdgcn_exp2f((s23[0] - M) * L2E) + s23[3] * __builtin_amdgcn_exp2f((s23[2] - M) * L2E);
                const float mine = wc == 0 ? s01[0] : (wc == 1 ? s01[2] : (wc == 2 ? s23[0] : s23[2]));
                const float f = __builtin_amdgcn_exp2f((mine - M) * L2E) / L;
                bf16_t* rp = Pout + (size_t)u.pm * (XSP_1024 / 2) + (size_t)(row0 + ai * 128 + m * 16) * DM + col0;
#pragma unroll
                for (int bj = 0; bj < 2; ++bj) *(u32x4*)(rp + bj * 128) = pack8(acc[ai][bj][m][0] * f, acc[ai][bj][m][1] * f);
            }
    }
};

struct KVOrder {
    int G, c; const char* memn; const char* wt;
    int local, x, t;
    __device__ void fill(Unit& u, int seg, int pm, int pn) const {
        const char* lw = wt + (size_t)(seg >> 1) * LW; u.seg = seg; u.pm = pm; u.pn = pn;
        u.A = memn + (size_t)pm * 256 * 1024 * 2; u.B = lw + OFF_WK + (size_t)(seg & 1) * (OFF_WV - OFF_WK) + (size_t)pn * 256 * 1024 * 2;
    }
    __device__ bool next(int i, Unit& u) const {
        if (local) { if (i > 0 || t >= 16) return false; fill(u, t >> 2, x, t & 3); return true; }
        const int L = i * G + c; if (L >= 128) return false;
        fill(u, L >> 5, L & 7, (L & 31) >> 3); return true;
    }
};
struct PreOrder {
    int G, c; const char* wt; const char* kb; const char* vb;
    int local, x, t;
    __device__ void fill(Unit& u, int b, int uu) const {
        const int kind = uu >> 5, v = uu & 31, l = v >> 4, h = (v >> 2) & 3, j = v & 3; const char* lw = wt + (size_t)l * LW;
        u.seg = kind * 16 + l * 8 + b;
        if (kind == 0) { u.pm = h; u.pn = j; u.A = kb + ((size_t)l * 2048 * 1024 + (size_t)b * 256 * 1024 + h * 256) * 2; u.B = lw + OFF_WQ + ((size_t)j * 256 * 1024 + h * 256) * 2; }
        else { u.pm = j; u.pn = h; u.A = lw + OFF_WXO + ((size_t)j * 256 * 1024 + h * 256) * 2; u.B = vb + ((size_t)l * 2048 * 1024 + (size_t)b * 256 * 1024 + h * 256) * 2; }
    }
    __device__ bool next(int i, Unit& u) const {
        if (local) { if (i > 1) return false; fill(u, x, t + 32 * i); return true; }
        const int L = i * G + c; if (L >= 512) return false;
        fill(u, L >> 6, L & 63); return true;
    }
};
struct BranchOrder {
    pg8::StaticOrder so; const char* P; const char* W;
    __device__ bool next(int i, Unit& u) const {
        int pm, pn; if (!so.tile(i / 3, pm, pn)) return false; const int seg = i % 3;
        u.pm = pm; u.pn = pn; u.seg = seg;
        const int acol = seg == 0 ? 0 : (seg == 1 ? 1024 : 512);
        u.A = P + ((size_t)pm * 256 * INC + acol) * 2; u.B = W + (size_t)seg * (1024 * 512 * 2) + (size_t)pn * 256 * 512 * 2; return true;
    }
};
template <int MODE>
__device__ __forceinline__ void conv_weight(const float* W, int ldn, int K, int N, const float* kscale, float mul, bf16_t* WT, LAS float* scr, int gw, int NGW, int lane, int& off) {
    const int nblk = N / 32, nitems = (K / 64) * nblk;
    const int first = (gw + NGW - (off % NGW)) % NGW; off += nitems;
    for (int it = first; it < nitems; it += NGW) {
        const int kb = it / nblk, nb = it % nblk, k0 = 64 * kb, n0 = 32 * nb;
        float wv[32];
#pragma unroll
        for (int i = 0; i < 32; ++i) wv[i] = W[(size_t)(k0 + 2 * i + (lane >> 5)) * ldn + n0 + (lane & 31)];
#pragma unroll
        for (int i = 0; i < 32; ++i) { const int kk = 2 * i + (lane >> 5); const float sc = kscale ? kscale[k0 + kk] * mul : mul; scr[kk * 33 + (lane & 31)] = wv[i] * sc; }
        asm volatile("s_waitcnt lgkmcnt(0)" ::: "memory");
        const int c = lane & 7;
#pragma unroll
        for (int j = 0; j < 4; ++j) { const int n = (lane >> 3) + 8 * j; const LAS float* s = scr + (8 * c) * 33 + n;
            u32x4 o; o.x = pk2(s[0 * 33], s[1 * 33]); o.y = pk2(s[2 * 33], s[3 * 33]); o.z = pk2(s[4 * 33], s[5 * 33]); o.w = pk2(s[6 * 33], s[7 * 33]);
            int col = n0 + n, drow = col;
            if (MODE == 1) { const int isup = col >= FFH, hh = isup ? col - FFH : col; drow = 8 * (hh >> 2) + (hh & 3) + (isup ? 4 : 0); }
            if (MODE == 2) { if (col >= 1536 && col < 2560) { const int isx = col >= 2048, cc = isx ? col - 2048 : col - 1536; drow = 1536 + 8 * (cc >> 2) + (cc & 3) + (isx ? 4 : 0); } }
            *(u32x4*)(WT + (size_t)drow * K + k0 + 8 * c) = o; }
        asm volatile("s_waitcnt lgkmcnt(0)" ::: "memory");
    }
}

struct Args { const float* in[25]; float* out; unsigned char* ws; };

__device__ __forceinline__ void prologue(const Args& a, LAS unsigned char* lds, int wave_s) {
    const int tid_ = phase_tid(wave_s); const int tid = tid_, lane = tid & 63, wave = __builtin_amdgcn_readfirstlane(tid >> 6);
    unsigned char* ws = a.ws;
    LAS float* scr = (LAS float*)(lds + wave * 16384);
    const int gw = blockIdx.x * 8 + wave, NGW = gridDim.x * 8;
    const int gt = blockIdx.x * 512 + tid, NGT = gridDim.x * 512;
    int woff = 0;
    for (int l = 0; l < 2; ++l) {
        unsigned char* lw = ws + WS_WT + (size_t)l * LW;
        conv_weight<2>(a.in[3] + (size_t)l * DM * INC, INC, DM, INC, a.in[2] + l * DM, 1.f, (bf16_t*)(lw + OFF_WIN), scr, gw, NGW, lane, woff);
        conv_weight<0>(a.in[12] + (size_t)l * 512 * DM, DM, 512, DM, nullptr, 1.f, (bf16_t*)(lw + OFF_WA), scr, gw, NGW, lane, woff);
        conv_weight<0>(a.in[13] + (size_t)l * 512 * DM, DM, 512, DM, nullptr, 1.f, (bf16_t*)(lw + OFF_WA + 1 * MiB), scr, gw, NGW, lane, woff);
        conv_weight<0>(a.in[14] + (size_t)l * 512 * DM, DM, 512, DM, nullptr, 1.f, (bf16_t*)(lw + OFF_WA + 2 * MiB), scr, gw, NGW, lane, woff);
        conv_weight<0>(a.in[15] + (size_t)l * DM * DM, DM, DM, DM, nullptr, 1.f, (bf16_t*)(lw + OFF_WO), scr, gw, NGW, lane, woff);
        { const float* wq = a.in[18] + (size_t)l * DM * DM; const float* gq = a.in[16] + l * DM; bf16_t* dq = (bf16_t*)(lw + OFF_WQ);
          for (int e = gt * 4; e < DM * DM; e += NGT * 4) { const f32x4 v = *(const f32x4*)(wq + e); const float sc = gq[e >> 10] * 0.0625f; u32x2 w; w.x = cvt_pk_bf16(v[0] * sc, v[1] * sc); w.y = cvt_pk_bf16(v[2] * sc, v[3] * sc); *(u32x2*)(dq + e) = w; } }
        conv_weight<0>(a.in[19] + (size_t)l * DM * 2048, 2048, DM, DM, a.in[17] + l * DM, 1.f, (bf16_t*)(lw + OFF_WK), scr, gw, NGW, lane, woff);
        conv_weight<0>(a.in[19] + (size_t)l * DM * 2048 + 1024, 2048, DM, DM, a.in[17] + l * DM, 1.f, (bf16_t*)(lw + OFF_WV), scr, gw, NGW, lane, woff);
        conv_weight<0>(a.in[20] + (size_t)l * DM * DM, DM, DM, DM, nullptr, 1.f, (bf16_t*)(lw + OFF_WXO), scr, gw, NGW, lane, woff);
        conv_weight<1>(a.in[22] + (size_t)l * DM * 2 * FFH, 2 * FFH, DM, 2 * FFH, a.in[21] + l * DM, 1.f, (bf16_t*)(lw + OFF_WFI), scr, gw, NGW, lane, woff);
        conv_weight<0>(a.in[23] + (size_t)l * FFH * DM, DM, FFH, DM, nullptr, 1.f, (bf16_t*)(lw + OFF_WFO), scr, gw, NGW, lane, woff);
        bf16_t* wsd = (bf16_t*)(lw + OFF_WS); bf16_t* wgd = (bf16_t*)(lw + OFF_WG);
        const float* aws = a.in[7] + (size_t)l * 65536; const float* cwg = a.in[10] + (size_t)l * 65536; const float* csc = a.in[11] + l * 512;
        for (int e = gt; e < 65536; e += NGT) {
            const int i = (e >> 7) & 127, j = e & 127; wsd[e] = (bf16_t)f2bf(j <= i ? aws[e] : 0.f);
            const int gi = e >> 14, d = (e >> 7) & 127, c = e & 127; wgd[e] = (bf16_t)f2bf(cwg[(gi * 128 + c) * 128 + d] * csc[gi * 128 + d]);
        }
    }
    bf16_t* XB = (bf16_t*)(ws + WS_XB); float* ssq = (float*)(ws + WS_SSQ);
    for (int r = gw; r < MTOK; r += 2 * NGW) {
        const int r2 = r + NGW; const bool has2 = r2 < MTOK;
        const f32x4* xr = (const f32x4*)(a.in[0] + (size_t)r * DM) + lane; const f32x4* xr2 = (const f32x4*)(a.in[0] + (size_t)(has2 ? r2 : r) * DM) + lane;
        f32x4 v[4], v2[4]; float s = 0.f, s2 = 0.f;
#pragma unroll
        for (int j = 0; j < 4; ++j) { v[j] = xr[64 * j]; v2[j] = xr2[64 * j]; }
#pragma unroll
        for (int j = 0; j < 4; ++j) { s += (v[j][0] * v[j][0] + v[j][1] * v[j][1]) + (v[j][2] * v[j][2] + v[j][3] * v[j][3]); s2 += (v2[j][0] * v2[j][0] + v2[j][1] * v2[j][1]) + (v2[j][2] * v2[j][2] + v2[j][3] * v2[j][3]); }
        s = wave_sum(s); s2 = wave_sum(s2);
        u32x2* o = (u32x2*)(XB + (size_t)r * DM) + lane;
#pragma unroll
        for (int j = 0; j < 4; ++j) { u32x2 w; w.x = cvt_pk_bf16(v[j][0], v[j][1]); w.y = cvt_pk_bf16(v[j][2], v[j][3]); o[64 * j] = w; }
        if (lane < 4) ssq[(size_t)r * 4 + lane] = lane == 0 ? s : 0.f;
        if (has2) {
            u32x2* o2 = (u32x2*)(XB + (size_t)r2 * DM) + lane;
#pragma unroll
            for (int j = 0; j < 4; ++j) { u32x2 w; w.x = cvt_pk_bf16(v2[j][0], v2[j][1]); w.y = cvt_pk_bf16(v2[j][2], v2[j][3]); o2[64 * j] = w; }
            if (lane < 4) ssq[(size_t)r2 * 4 + lane] = lane == 0 ? s2 : 0.f;
        }
    }
    bf16_t* MN = (bf16_t*)(ws + WS_MEMN);
    for (int r = gw; r < MEMROWS; r += NGW) {
        const f32x4* xr = (const f32x4*)(a.in[1] + (size_t)r * DM) + lane; f32x4 v[4]; float s = 0.f;
#pragma unroll
        for (int j = 0; j < 4; ++j) { v[j] = xr[64 * j]; s += (v[j][0] * v[j][0] + v[j][1] * v[j][1]) + (v[j][2] * v[j][2] + v[j][3] * v[j][3]); }
        s = wave_sum(s); const float rs = __builtin_amdgcn_rsqf(s * (1.0f / 1024.0f) + EPSV);
        u32x2* o = (u32x2*)(MN + (size_t)r * DM) + lane;
#pragma unroll
        for (int j = 0; j < 4; ++j) { u32x2 w; w.x = cvt_pk_bf16(v[j][0] * rs, v[j][1] * rs); w.y = cvt_pk_bf16(v[j][2] * rs, v[j][3] * rs); o[64 * j] = w; }
    }
}

__device__ __forceinline__ void mixer_phase(LAS unsigned char* lds, bf16_t* P, const bf16_t* Wtril, const bf16_t* WgT, const float* ln_g, const float* ln_b,
                                            const float* a_bs, const float* bconv, int wave_s, int ch0, int chstep, int chend) {
    const int w = wave_s;
    LAS bf16_t* T = (LAS bf16_t*)lds;
    LAS bf16_t* Pp = (LAS bf16_t*)lds;
    for (int ch = ch0; ch < chend; ch += chstep) {
        const size_t row0 = (size_t)ch * 128; const int pos0 = (ch * 128) % SEQL;
        const int lane = phase_tid(0), fr = lane & 15, fq = lane >> 4;
        __syncthreads();
        {
            float lg[8], lb[8];
#pragma unroll
            for (int e = 0; e < 4; ++e) { lg[2 * e] = ln_g[128 * e + 2 * lane]; lg[2 * e + 1] = ln_g[128 * e + 2 * lane + 1]; lb[2 * e] = ln_b[128 * e + 2 * lane]; lb[2 * e + 1] = ln_b[128 * e + 2 * lane + 1]; }
#pragma unroll 1
            for (int jj = 0; jj < 16; jj += 8) {
                unsigned raw[8][4];
#pragma unroll
                for (int r = 0; r < 8; ++r)
#pragma unroll
                    for (int e = 0; e < 4; ++e) raw[r][e] = *(const unsigned*)(P + (row0 + 16 * w + jj + r) * INC + 512 + 128 * e + 2 * lane);
#pragma unroll
                for (int r = 0; r < 8; ++r) {
                    float v[8]; float s = 0.f, q = 0.f;
#pragma unroll
                    for (int e = 0; e < 4; ++e) { v[2 * e] = bf_lo(raw[r][e]); v[2 * e + 1] = bf_hi(raw[r][e]); s += v[2 * e] + v[2 * e + 1]; q += v[2 * e] * v[2 * e] + v[2 * e + 1] * v[2 * e + 1]; }
                    s = wave_sum(s); q = wave_sum(q);
                    const float mean = s * (1.0f / 512.0f), var = fmaxf(q * (1.0f / 512.0f) - mean * mean, 0.f), rstd = __builtin_amdgcn_rsqf(var + EPSV);
                    const int j = 16 * w + jj + r;
#pragma unroll
                    for (int e = 0; e < 4; ++e)
#pragma unroll
                        for (int h = 0; h < 2; ++h) T[(128 * e + 2 * lane + h) * 132 + j] = (bf16_t)f2bf((v[2 * e + h] - mean) * rstd * lg[2 * e + h] + lb[2 * e + h]);
                }
            }
        }
        {
            f32x4 w0a, w0b, w1a, w1b, w2a, w2b;
            { const f32x4* bc = (const f32x4*)(bconv + 8 * lane); w0a = bc[0]; w0b = bc[1]; w1a = bc[128]; w1b = bc[129]; w2a = bc[256]; w2b = bc[257]; }
            const size_t R = row0 + 16 * w; const int pos = pos0 + 16 * w;
            bf16_t* base = P + R * INC + 1024 + 8 * lane;
            f32x4 y1a = (f32x4){0.f, 0.f, 0.f, 0.f}, y1b = y1a, y2a = y1a, y2b = y1a;
            if (pos > 0) { unpack8(*(const u32x4*)(base - (size_t)INC + 512), y1a, y1b); unpack8(*(const u32x4*)(base - 2 * (size_t)INC + 512), y2a, y2b); }
#pragma unroll 8
            for (int t = 0; t < 16; ++t) {
                bf16_t* rp = base + (size_t)t * INC;
                f32x4 ga, gb, y0a, y0b;
                unpack8(*(const u32x4*)(rp), ga, gb); unpack8(*(const u32x4*)(rp + 512), y0a, y0b);
                const f32x4 oa = ga * (w0a * y2a + w1a * y1a + w2a * y0a), ob = gb * (w0b * y2b + w1b * y1b + w2b * y0b);
                *(u32x4*)(rp) = pack8(oa, ob);
                y2a = y1a; y2b = y1b; y1a = y0a; y1b = y0b;
            }
        }
        __syncthreads();
        {
#pragma unroll 1
            for (int g = 0; g < 4; ++g) {
                bf16x8 wf[4];
#pragma unroll
                for (int ks = 0; ks < 4; ++ks) wf[ks] = *(const bf16x8*)(Wtril + ((g * 128 + 16 * w + fr) * 128 + 32 * ks + 8 * fq));
                const float bsv = a_bs[g * 128 + 16 * w + fr];
                bf16_t* up = P + (row0 + 16 * w + fr) * INC + g * 128 + 4 * fq;
                u32x2 uv[8];
#pragma unroll
                for (int db = 0; db < 8; ++db) uv[db] = *(const u32x2*)(up + 16 * db);
#pragma unroll
                for (int db = 0; db < 8; ++db) {
                    f32x4 acc = (f32x4){0.f, 0.f, 0.f, 0.f};
#pragma unroll
                    for (int ks = 0; ks < 4; ++ks) {
                        const LAS u32x2* tp = (const LAS u32x2*)(T + (g * 128 + 16 * db + fr) * 132 + 32 * ks + 8 * fq);
                        const u32x2 t0 = tp[0], t1 = tp[1]; u32x4 tw; tw.x = t0.x; tw.y = t0.y; tw.z = t1.x; tw.w = t1.y;
                        acc = __builtin_amdgcn_mfma_f32_16x16x32_bf16(__builtin_bit_cast(bf16x8, tw), wf[ks], acc, 0, 0, 0);
                    }
                    u32x2 o; o.x = cvt_pk_bf16(bf_lo(uv[db].x) * (acc[0] + bsv), bf_hi(uv[db].x) * (acc[1] + bsv)); o.y = cvt_pk_bf16(bf_lo(uv[db].y) * (acc[2] + bsv), bf_hi(uv[db].y) * (acc[3] + bsv));
                    *(u32x2*)(up + 16 * db) = o;
                }
            }
        }
        __syncthreads();
        {
            const int lane_c = phase_tid(0);
            const int gi = lane_c >> 4, win = 2 << gi;
            const size_t R = row0 + 16 * w; const int pos = pos0 + 16 * w;
            const bf16_t* zc = P + R * INC + 2560 + 8 * lane_c;
            u32x4 oldr[16], ownr[16];
#pragma unroll
            for (int t = 0; t < 16; ++t) { const bool ok = (pos + t - win) >= 0; const long off = ok ? (long)(t - win) * INC : 0; oldr[t] = *(const u32x4*)(zc + off); if (!ok) oldr[t] = (u32x4){0u, 0u, 0u, 0u}; }
#pragma unroll
            for (int t = 0; t < 16; ++t) ownr[t] = *(const u32x4*)(zc + (size_t)t * INC);
            f32x4 Sa = (f32x4){0.f, 0.f, 0.f, 0.f}, Sb = Sa;
#pragma unroll
            for (int t = 0; t < 16; ++t) { f32x4 oa, ob; unpack8(oldr[t], oa, ob); if (t < win) { Sa += oa; Sb += ob; } }
#pragma unroll
            for (int t = 0; t < 16; ++t) {
                f32x4 za, zb, oa, ob; unpack8(ownr[t], za, zb); unpack8(oldr[t], oa, ob);
                Sa += za - oa; Sb += zb - ob;
                const int cnt = (pos + t + 1) < win ? (pos + t + 1) : win; const float ic = __builtin_amdgcn_rcpf((float)cnt);
                *(LAS u32x4*)(Pp + (16 * w + t) * 520 + 8 * lane_c) = pack8(Sa * ic - za, Sb * ic - zb);
            }
        }
        __syncthreads();
        {
#pragma unroll 1
            for (int gi = 0; gi < 4; ++gi) {
                bf16x8 pf[4];
#pragma unroll
                for (int ks = 0; ks < 4; ++ks) pf[ks] = *(const LAS bf16x8*)(Pp + (16 * w + fr) * 520 + gi * 128 + 32 * ks + 8 * fq);
#pragma unroll 8
                for (int db = 0; db < 8; ++db) {
                    f32x4 acc = (f32x4){0.f, 0.f, 0.f, 0.f};
#pragma unroll
                    for (int ks = 0; ks < 4; ++ks) {
                        const bf16x8 wfr = *(const bf16x8*)(WgT + ((gi * 128 + 16 * db + fr) * 128 + 32 * ks + 8 * fq));
                        acc = __builtin_amdgcn_mfma_f32_16x16x32_bf16(wfr, pf[ks], acc, 0, 0, 0);
                    }
                    u32x2 o; o.x = cvt_pk_bf16(acc[0], acc[1]); o.y = cvt_pk_bf16(acc[2], acc[3]);
                    *(u32x2*)(P + (row0 + 16 * w + fr) * INC + 512 + gi * 128 + 16 * db + 4 * fq) = o;
                }
            }
        }
    }
}

#define XB_TMO      128
#define XB_XCNT(j)  (256  + 64 * (j))
#define XB_XSUB(j)  (1280 + 64 * (j))
#define XB_XGEN(j)  (2304 + 64 * (j))
#define XB_TOP      3328
#define XB_TOPGEN   3392
#define XB_TEAM(j)  (3456 + 64 * (j))
#define XCD_BAR_WORDS (3456 + 64 * 64)
#define XB_SPIN_CAP (1u << 20)
__device__ __forceinline__ unsigned xb_ld(unsigned* p)              { return __hip_atomic_load(p, __ATOMIC_RELAXED, __HIP_MEMORY_SCOPE_AGENT); }
__device__ __forceinline__ unsigned xb_add(unsigned* p, unsigned v) { return __hip_atomic_fetch_add(p, v, __ATOMIC_RELAXED, __HIP_MEMORY_SCOPE_AGENT); }
__device__ __forceinline__ unsigned xb_xcc_id() { return (unsigned)__builtin_amdgcn_s_getreg((3 << 11) | 20) & 0xFu; }
#define XB_SPIN(cond, bar) do { unsigned _sp = 0; while (cond) { __builtin_amdgcn_s_sleep(1); \
    if ((++_sp & 255u) == 0u) { if (xb_ld(&(bar)[XB_TMO])) break; if (_sp > XB_SPIN_CAP) { atomicAdd(&(bar)[XB_TMO], 1u); break; } } } } while (0)
struct XcdBarrier { unsigned* bar; unsigned x; volatile LAS unsigned* st; };
__device__ __forceinline__ XcdBarrier xcd_barrier_post(unsigned* bar, volatile LAS unsigned* st, bool leader) {
    XcdBarrier b; b.bar = bar; b.x = xb_xcc_id(); b.st = st;
    if (leader) (void)xb_add(&bar[XB_XCNT(b.x)], 1u);
    return b;
}
__device__ __forceinline__ void xcd_barrier_complete(unsigned* bar, unsigned x, unsigned& nloc, unsigned& nx) {
    const unsigned G = gridDim.x * gridDim.y * gridDim.z;
    unsigned sum, cnt, mine, sp = 0u;
    for (;;) {
        sum = 0u; cnt = 0u; mine = 0u;
#pragma unroll
        for (unsigned j = 0; j < 16; ++j) { const unsigned c = xb_ld(&bar[XB_XCNT(j)]); sum += c; cnt += (c > 0u) ? 1u : 0u; mine = (j == x) ? c : mine; }
        if (sum == G) break;
        __builtin_amdgcn_s_sleep(1);
        if ((++sp & 255u) == 0u) { if (xb_ld(&bar[XB_TMO])) break; if (sp > XB_SPIN_CAP) { atomicAdd(&bar[XB_TMO], 1u); break; } }
    }
    nloc = mine > 0u ? mine : 1u; nx = cnt > 0u ? cnt : 1u;
}
__device__ __forceinline__ void xcd_barrier(const XcdBarrier& b, bool leader) {
    asm volatile("s_waitcnt vmcnt(0)" ::: "memory");
    __syncthreads();
    if (leader) {
        unsigned* bar = b.bar;
        __builtin_amdgcn_s_waitcnt(0);
        unsigned nloc = b.st[0], nx = b.st[1];
        if (nloc == 0u) { xcd_barrier_complete(bar, b.x, nloc, nx); b.st[0] = nloc; b.st[1] = nx; }
        const unsigned old = xb_add(&bar[XB_XSUB(b.x)], 1u);
        const unsigned gen = old / nloc;
        if (old + 1u == (gen + 1u) * nloc) {
            __builtin_amdgcn_fence(__ATOMIC_RELEASE, "agent");
            asm volatile("s_waitcnt vmcnt(0)" ::: "memory");
            const unsigned og = xb_add(&bar[XB_TOP], 1u);
            const unsigned tg = og / nx;
            if (og + 1u == (tg + 1u) * nx) xb_add(&bar[XB_TOPGEN], 1u);
            else XB_SPIN(xb_ld(&bar[XB_TOPGEN]) == tg, bar);
            __builtin_amdgcn_fence(__ATOMIC_ACQUIRE, "agent");
            xb_add(&bar[XB_XGEN(b.x)], 1u);
            asm volatile("s_waitcnt vmcnt(0)" ::: "memory");
        } else {
            XB_SPIN(xb_ld(&bar[XB_XGEN(b.x)]) == gen, bar);
            __builtin_amdgcn_fence(__ATOMIC_ACQUIRE, "agent");
            asm volatile("s_waitcnt vmcnt(0)" ::: "memory");
        }
    }
    __syncthreads();
}

__device__ __forceinline__ void xcc_local_barrier(unsigned* bar, unsigned widx, unsigned n, unsigned& epoch, bool leader) {
    asm volatile("s_waitcnt vmcnt(0)" ::: "memory");
    __syncthreads();
    if (leader) {
        __builtin_amdgcn_s_waitcnt(0);
        (void)xb_add(&bar[widx], 1u);
        const unsigned want = n * (epoch + 1u);
        XB_SPIN(xb_ld(&bar[widx]) < want, bar);
        __builtin_amdgcn_fence(__ATOMIC_ACQUIRE, "agent");
        asm volatile("s_waitcnt vmcnt(0)" ::: "memory");
    }
    ++epoch;
    __syncthreads();
}

__device__ __forceinline__ void counter_wait(unsigned* bar, unsigned widx, unsigned want, bool leader) {
    if (leader) {
        XB_SPIN(xb_ld(&bar[widx]) < want, bar);
        __builtin_amdgcn_fence(__ATOMIC_ACQUIRE, "agent");
        asm volatile("s_waitcnt vmcnt(0)" ::: "memory");
    }
    __syncthreads();
}

__device__ __forceinline__ unsigned char* opaque_ptr(unsigned char* p) { asm volatile("" : "+s"(p)); return p; }
#define PHASE_PTRS() unsigned char* wsp = opaque_ptr(a.ws); (void)wsp; const char* lw = (const char*)(wsp + WS_WT + (size_t)l * LW); (void)lw; \
    bf16_t* XB = (bf16_t*)(wsp + WS_XB); (void)XB; float* ssq = (float*)(wsp + WS_SSQ); (void)ssq; bf16_t* PROJ = (bf16_t*)(wsp + WS_PROJ); (void)PROJ

__global__ void __launch_bounds__(512, 2) fwd_megakernel(Args a) {
    extern __shared__ __attribute__((aligned(16))) unsigned char lds_raw[];
    LAS unsigned char* lds = (LAS unsigned char*)lds_raw;
    cg::grid_group grid = cg::this_grid();
    const int G = gridDim.x;
    const int wave_s = __builtin_amdgcn_readfirstlane(threadIdx.x >> 6);

    const bool leader = (wave_s == 0) && (phase_tid(0) == 0);
    volatile LAS unsigned* bst = (volatile LAS unsigned*)(lds + LDS_MISC);
    const unsigned xcc = xb_xcc_id();
    if (leader) { bst[0] = 0u; bst[1] = 0u; bst[2] = xb_add((unsigned*)a.ws + XB_XCNT(xcc), 1u); }
    __syncthreads();
    XcdBarrier xbar; xbar.bar = (unsigned*)a.ws; xbar.x = xcc; xbar.st = bst;
    prologue(a, lds, wave_s);
    if (G == 256) xcd_barrier(xbar, leader); else CG_GRID_SYNC();
    if (leader) { unsigned ok = (G == 256) ? 1u : 0u;
#pragma unroll
        for (unsigned j2 = 0; j2 < 8; ++j2) ok &= (xb_ld((unsigned*)a.ws + XB_XCNT(j2)) == 32u) ? 1u : 0u;
        bst[3] = ok; }
    __syncthreads();
    const unsigned ticket = (unsigned)__builtin_amdgcn_readfirstlane((int)bst[2]);
    const bool local_ok = __builtin_amdgcn_readfirstlane((int)bst[3]) != 0;
    const int cidx = local_ok ? (int)(xcc + 8u * ticket) : (int)blockIdx.x;
    unsigned epoch_t = 0u;
    unsigned epoch = (G == 256) ? 1u : 0u;
    {
        unsigned char* wsp = opaque_ptr(a.ws);
        KVOrder S{G, cidx, (const char*)(wsp + WS_MEMN), (const char*)(wsp + WS_WT), local_ok ? 1 : 0, (int)xcc, (int)ticket};
        EpiKV E{(bf16_t*)(wsp + WS_KB), (bf16_t*)(wsp + WS_VT)};
        pg8::gemm_phase(lds, pg8::Gemm{1024, 1024, 1024}, S, E, wave_s);
    }
    GRID_SYNC();
    {
        unsigned char* wsp = opaque_ptr(a.ws);
        PreOrder S{G, cidx, (const char*)(wsp + WS_WT), (const char*)(wsp + WS_KB), (const char*)(wsp + WS_VT), local_ok ? 1 : 0, (int)xcc, (int)ticket};
        EpiPre E{(bf16_t*)a.out};
        pg8::gemm_phase(lds, pg8::Gemm{256, 1024, 1024}, S, E, wave_s);
    }
#pragma unroll 1
    for (int l = 0; l < 2; ++l) {
        {
            PHASE_PTRS();
            pg8::PlainOrder S; S.so.init(MTOK, INC, G, cidx); S.A = (const char*)XB; S.B = lw + OFF_WIN; S.astep = (size_t)256 * DM * 2; S.bstep = (size_t)256 * DM * 2; S.axs = 0;
            EpiInProj E{PROJ, ssq, a.in[4] + l * 3 * DM};
            pg8::gemm_phase(lds, pg8::Gemm{DM, DM, DM}, S, E, wave_s);
        }
        TEAM_SYNC();
        if (local_ok) counter_wait((unsigned*)a.ws, XB_TEAM(8u * xcc + ((ticket + 7u) & 7u)), 4u * epoch_t, leader);
        {
            PHASE_PTRS();
            const int ch0 = local_ok ? (int)(2u * (32u * xcc + ticket)) : (int)blockIdx.x, chstep = local_ok ? 1 : G, chend = local_ok ? ch0 + 2 : MTOK / 128;
            mixer_phase(lds, PROJ, (const bf16_t*)(lw + OFF_WS), (const bf16_t*)(lw + OFF_WG), a.in[5] + l * 512, a.in[6] + l * 512, a.in[8] + l * 512, a.in[9] + l * 1536, wave_s, ch0, chstep, chend);
        }
        GRID_SYNC();
        {
            PHASE_PTRS();
            BranchOrder S; S.so.init(MTOK, DM, G, cidx); S.P = (const char*)PROJ; S.W = lw + OFF_WA;
            EpiBranch E{PROJ};
            pg8::gemm_phase(lds, pg8::Gemm{512, INC, 512}, S, E, wave_s);
        }
        TEAM_SYNC();
        {
            PHASE_PTRS();
            pg8::PlainOrder S; S.so.init(MTOK, DM, G, cidx); S.A = (const char*)(PROJ + 1536); S.B = lw + OFF_WO; S.astep = (size_t)256 * INC * 2; S.bstep = (size_t)256 * DM * 2; S.axs = 0;
            EpiResid E{XB, ssq, (LAS float*)(lds + LDS_STAT)};
            pg8::gemm_phase(lds, pg8::Gemm{DM, INC, DM}, S, E, wave_s);
        }
        TEAM_SYNC();
        {
            PHASE_PTRS();
            pg8::PlainOrder S; S.so.init(MTOK, DM, G, cidx); S.A = (const char*)XB; S.B = (const char*)a.out + (size_t)l * 2 * MiB; S.astep = (size_t)256 * DM * 2; S.bstep = (size_t)256 * DM * 2; S.axs = 0; S.bxs = 32 * MiB;
            EpiSoftmax E{(bf16_t*)(wsp + WS_PROJ + PJ_P), (LAS float*)(lds + LDS_STAT), ssq};
            pg8::gemm_phase(lds, pg8::Gemm{DM, DM, DM}, S, E, wave_s);
        }
        TEAM_SYNC();
        {
            PHASE_PTRS();
            pg8::PlainOrder S; S.so.init(MTOK, DM, G, cidx); S.A = (const char*)(wsp + WS_PROJ + PJ_P); S.B = (const char*)a.out + 4 * MiB + (size_t)l * 2 * MiB; S.astep = (size_t)256 * DM * 2; S.bstep = (size_t)256 * DM * 2; S.axs = XSP_1024; S.bxs = 32 * MiB;
            EpiResid E{XB, ssq, (LAS float*)(lds + LDS_STAT)};
            pg8::gemm_phase(lds, pg8::Gemm{DM, DM, DM}, S, E, wave_s);
        }
        TEAM_SYNC();
        {
            PHASE_PTRS();
            pg8::PlainOrder S; S.so.init(MTOK, 2 * FFH, G, cidx); S.A = (const char*)XB; S.B = lw + OFF_WFI; S.astep = (size_t)256 * DM * 2; S.bstep = (size_t)256 * DM * 2; S.axs = 0;
            EpiSwiglu E{(bf16_t*)(wsp + WS_PROJ + PJ_H), ssq};
            pg8::gemm_phase(lds, pg8::Gemm{DM, DM, DM}, S, E, wave_s);
        }
        TEAM_SYNC();
        {
            PHASE_PTRS();
            pg8::PlainOrder S; S.so.init(MTOK, DM, G, cidx); S.A = (const char*)(wsp + WS_PROJ + PJ_H); S.B = lw + OFF_WFO; S.astep = (size_t)256 * FFH * 2; S.bstep = (size_t)256 * FFH * 2; S.axs = XSP_FFH;
            EpiResid E{XB, ssq, (LAS float*)(lds + LDS_STAT)};
            pg8::gemm_phase(lds, pg8::Gemm{FFH, FFH, FFH}, S, E, wave_s);
        }
        if (l == 1) GRID_SYNC(); else TEAM_SYNC();
    }
    {
        const int l = 0; PHASE_PTRS();
        const int lane = phase_tid(0), wave = wave_s;
        const float* gf = a.in[24];
        f32x4 g0[2], g1[2];
#pragma unroll
        for (int e = 0; e < 2; ++e) { g0[e] = *(const f32x4*)(gf + 512 * e + 8 * lane); g1[e] = *(const f32x4*)(gf + 512 * e + 8 * lane + 4); }
        const int r0 = local_ok ? (int)(8192u * xcc + 8u * ticket) + wave : (int)blockIdx.x * 8 + wave, rstep = local_ok ? 256 : G * 8, rend = local_ok ? (int)(8192u * xcc + 8192u) : MTOK;
        for (int r = r0; r < rend; r += rstep) {
            float s = (lane < 4) ? ssq[(size_t)r * 4 + lane] : 0.f; s = wave_sum(s);
            const float rs = __builtin_amdgcn_rsqf(s * (1.0f / 1024.0f) + EPSV);
#pragma unroll
            for (int e = 0; e < 2; ++e) {
                f32x4 x0, x1; unpack8(*(const u32x4*)(XB + (size_t)r * DM + 512 * e + 8 * lane), x0, x1);
                float* op = a.out + (size_t)r * DM + 512 * e + 8 * lane;
                *(f32x4*)op = x0 * rs * g0[e]; *(f32x4*)(op + 4) = x1 * rs * g1[e];
            }
        }
    }
}

extern "C" void kernel_launch(void* const* d_in, const int* in_sizes, int n_in, void* d_out, int out_size, void* d_ws, size_t ws_size, hipStream_t stream) {
    static int grid = 0;
    if (grid == 0) {
        if (n_in != 25 || in_sizes[0] != MTOK * DM || out_size != MTOK * DM || ws_size < WS_END) {
            fprintf(stderr, "kernel_launch: unexpected shapes (n_in %d, in0 %d, out %d, ws %zu < %zu); nothing launched\n", n_in, n_in > 0 ? in_sizes[0] : -1, out_size, ws_size, (size_t)WS_END); grid = -1; return; }
        int dev = 0, cus = 0, per_cu = 0;
        hipGetDevice(&dev); hipDeviceGetAttribute(&cus, hipDeviceAttributeMultiprocessorCount, dev);
        if (hipFuncSetAttribute((const void*)fwd_megakernel, hipFuncAttributeMaxDynamicSharedMemorySize, LDS_BYTES) != hipSuccess) { fprintf(stderr, "kernel_launch: hipFuncSetAttribute failed\n"); grid = -1; return; }
        if (hipOccupancyMaxActiveBlocksPerMultiprocessor(&per_cu, (const void*)fwd_megakernel, 512, LDS_BYTES) != hipSuccess || per_cu < 1) { fprintf(stderr, "kernel_launch: occupancy query says %d blocks per CU\n", per_cu); per_cu = 1; }
        (void)hipGetLastError();
        grid = cus * per_cu;
    }
    if (grid < 0) return;
    if (hipMemsetAsync(d_ws, 0, XCD_BAR_WORDS * 4, stream) != hipSuccess) { fprintf(stderr, "kernel_launch: hipMemsetAsync failed\n"); return; }
    Args a{};
    for (int i = 0; i < 25; ++i) a.in[i] = (const float*)d_in[i];
    a.out = (float*)d_out; a.ws = (unsigned char*)d_ws;
    void* args[] = {&a};
    hipError_t e = hipLaunchCooperativeKernel((const void*)fwd_megakernel, dim3(grid), dim3(512), args, LDS_BYTES, stream);
    if (e != hipSuccess) fprintf(stderr, "kernel_launch: cooperative launch failed: %s (grid %d)\n", hipGetErrorString(e), grid);
}
```
